# Optimizing an MI355X kernel written in HIP

```python
import jax, jax.numpy as jnp
from jax import lax
import numpy as np

D_MODEL = 2048
BATCH = 4
SEQ = 2048
DEPTH = 4

HEAD_DIM = 64
RWKV_HEADS = 16
NSA_HEADS = 16
D_RWKV = RWKV_HEADS * HEAD_DIM
D_NSA = NSA_HEADS * HEAD_DIM
D_MIX = D_RWKV + D_NSA
DECAY_LORA = 96
AAA_LORA = 96
MV_LORA = 64
GATE_LORA = 256
GN_EPS = 64e-5
NSA_KV_HEADS = 4
NSA_KV = NSA_KV_HEADS * HEAD_DIM
CMP_BLOCK = 32
CMP_STRIDE = 16
CMP_HIDDEN = 256
SEL_BLOCK = 64
N_SELECT = 8
WINDOW = 512
Q_BLOCK = 128
ROPE_THETA = 10000.0
NEG = -1e30
FORCE = 1e4
D_FF = 4 * D_MODEL
LN_EPS = 1e-5
DN_ALPHA = (2 * DEPTH) ** 0.25
DN_BETA = (8 * DEPTH) ** -0.25
RWKV_COLS = 3 * D_RWKV + DECAY_LORA + AAA_LORA + GATE_LORA
NSA_COLS = D_NSA + 6 * NSA_KV + 3 * NSA_HEADS
IN_COLS = RWKV_COLS + NSA_COLS

kernel_name = "hymba_rwkv7_nsa_deepnorm_adaln"


def _layer_norm(x, g, b):
    xf = x.astype(jnp.float32)
    mu = xf.mean(-1, keepdims=True)
    var = jnp.mean(jnp.square(xf - mu), -1, keepdims=True)
    return ((xf - mu) * lax.rsqrt(var + LN_EPS) * g + b).astype(x.dtype)


def _rope(x, pos):
    half = HEAD_DIM // 2
    inv = ROPE_THETA ** (-jnp.arange(half, dtype=jnp.float32) / half)
    ang = pos.astype(jnp.float32)[:, None] * inv[None]
    cos = jnp.cos(ang)[None, :, None, :]
    sin = jnp.sin(ang)[None, :, None, :]
    x1, x2 = x[..., :half], x[..., half:]
    return jnp.concatenate([x1 * cos - x2 * sin, x2 * cos + x1 * sin], -1).astype(x.dtype)


def _token_shift(u):
    return jnp.pad(u, ((0, 0), (1, 0), (0, 0)))[:, :-1]


def _rwkv7_mix(u, v_first, mu, w0, w2, a0, a2, g2, k_k, k_a, r_k, lnx_g, lnx_b, v_res):
    B, T, _ = u.shape
    H, N = RWKV_HEADS, HEAD_DIM
    u = u + (_token_shift(u) - u) * mu
    r, k, v, xw, xa, xg = jnp.split(u, np.cumsum([D_RWKV] * 3 + [DECAY_LORA, AAA_LORA]).tolist(), axis=-1)
    w = -jax.nn.softplus(-(w0 + jnp.tanh(xw) @ w2)) - 0.5
    decay = jnp.exp(-jnp.exp(w.astype(jnp.float32)))
    a = jax.nn.sigmoid(a0 + xa @ a2)
    g = jax.nn.sigmoid(xg) @ g2
    if v_res is None:
        v_first = v
    else:
        v0, v1, v2 = v_res
        v = v + (v_first - v) * jax.nn.sigmoid(v0 + (v @ v1) @ v2)
    heads = lambda z: z.reshape(B, T, H, N).astype(jnp.float32)
    kk = heads(k * k_k)
    kk = kk / jnp.maximum(jnp.sqrt(jnp.sum(kk * kk, -1, keepdims=True)), 1e-12)
    k = k * (1 + (a - 1) * k_a)
    rh, kh, vh, ah, dh = heads(r), heads(k), heads(v), heads(a), heads(decay)

    def step(S, inp):
        r_t, w_t, k_t, v_t, kk_t, a_t = inp
        sa = jnp.einsum('bhvk,bhk->bhv', S, -kk_t)
        S = S * w_t[:, :, None, :] + sa[..., None] * (kk_t * a_t)[:, :, None, :] + v_t[..., None] * k_t[:, :, None, :]
        return S, jnp.einsum('bhvk,bhk->bhv', S, r_t)

    xs = tuple(jnp.moveaxis(z, 1, 0) for z in (rh, dh, kh, vh, kk, ah))
    _, o = lax.scan(step, jnp.zeros((B, H, N, N), jnp.float32), xs)
    o = jnp.moveaxis(o, 0, 1)
    mu_o = o.mean(-1, keepdims=True)
    var_o = jnp.mean(jnp.square(o - mu_o), -1, keepdims=True)
    o = ((o - mu_o) * lax.rsqrt(var_o + GN_EPS)).reshape(B, T, D_RWKV) * lnx_g + lnx_b
    bonus = jnp.sum(rh * kh * r_k, -1, keepdims=True) * vh
    o = (o + bonus.reshape(B, T, D_RWKV)) * g
    return o.astype(u.dtype), v_first


def _overlap_matrix(n_cmp, n_sel):
    pos = np.arange(n_cmp)[:, None] * CMP_STRIDE + np.arange(CMP_BLOCK)[None]
    m = ((pos // SEL_BLOCK)[..., None] == np.arange(n_sel)).sum(1) / CMP_BLOCK
    return jnp.asarray(m, jnp.float32)


def _compress(kv, pos_emb, w1, w2):
    B, T, G, N = kv.shape
    n_cmp = (T - CMP_BLOCK) // CMP_STRIDE + 1
    idx = np.arange(n_cmp)[:, None] * CMP_STRIDE + np.arange(CMP_BLOCK)[None]
    blocks = kv[:, idx] + pos_emb[:, None, :]
    blocks = jnp.transpose(blocks, (0, 3, 1, 2, 4)).reshape(B, G, n_cmp, CMP_BLOCK * N)
    return jax.nn.gelu(blocks @ w1) @ w2


def _nsa_mix(u, cmp_pos, cmp_w1, cmp_w2):
    B, T, _ = u.shape
    H, G, N = NSA_HEADS, NSA_KV_HEADS, HEAD_DIM
    HPG = H // G
    scale = N ** -0.5
    q, k_c, v_c, k_s, v_s, k_w, v_w, gate = jnp.split(u, np.cumsum([D_NSA] + [NSA_KV] * 6).tolist(), axis=-1)
    pos = jnp.arange(T)
    q = _rope(q.reshape(B, T, H, N), pos)
    k_c, k_s, k_w = (_rope(z.reshape(B, T, G, N), pos) for z in (k_c, k_s, k_w))
    v_c, v_s, v_w = (z.reshape(B, T, G, N) for z in (v_c, v_s, v_w))
    qg = q.reshape(B, T, G, HPG, N).transpose(0, 2, 3, 1, 4)

    kc = _compress(k_c, cmp_pos[0], cmp_w1[0], cmp_w2[0])
    vc = _compress(v_c, cmp_pos[1], cmp_w1[1], cmp_w2[1])
    n_cmp = kc.shape[2]
    cmask = (jnp.arange(n_cmp) * CMP_STRIDE + CMP_BLOCK - 1)[None, :] <= pos[:, None]
    s = jnp.einsum('bghtd,bgcd->bghtc', qg, kc).astype(jnp.float32) * scale
    p_cmp = jax.nn.softmax(jnp.where(cmask, s, NEG), -1) * cmask
    o_cmp = jnp.einsum('bghtc,bgcd->bghtd', p_cmp.astype(vc.dtype), vc)

    n_sel = T // SEL_BLOCK
    k_top = min(N_SELECT, n_sel)
    imp = jnp.einsum('bgtc,cs->bgts', p_cmp.sum(2), _overlap_matrix(n_cmp, n_sel))
    blk = jnp.arange(n_sel)[None]
    cur = (pos // SEL_BLOCK)[:, None]
    forced = (blk == 0) | (blk == cur) | (blk == cur - 1)
    causal = blk * SEL_BLOCK <= pos[:, None]
    imp = jnp.where(forced, FORCE, jnp.where(causal, imp, -1.0))
    _, sel_idx = lax.top_k(imp, k_top)

    ks_blocks = k_s.reshape(B, n_sel, SEL_BLOCK, G, N).transpose(0, 3, 1, 2, 4)
    vs_blocks = v_s.reshape(B, n_sel, SEL_BLOCK, G, N).transpose(0, 3, 1, 2, 4)
    kw_pad = jnp.pad(k_w, ((0, 0), (WINDOW, 0), (0, 0), (0, 0)))
    vw_pad = jnp.pad(v_w, ((0, 0), (WINDOW, 0), (0, 0), (0, 0)))
    n_q = T // Q_BLOCK
    q_blocks = qg.reshape(B, G, HPG, n_q, Q_BLOCK, N).transpose(3, 0, 1, 2, 4, 5)
    idx_blocks = sel_idx.reshape(B, G, n_q, Q_BLOCK, k_top).transpose(2, 0, 1, 3, 4)
    b_ix = jnp.arange(B)[:, None, None, None]
    g_ix = jnp.arange(G)[None, :, None, None]

    def block_attn(args):
        qi, qb, ib = args
        t = qi * Q_BLOCK + jnp.arange(Q_BLOCK)
        ksel = ks_blocks[b_ix, g_ix, ib]
        vsel = vs_blocks[b_ix, g_ix, ib]
        kpos = ib[..., None] * SEL_BLOCK + jnp.arange(SEL_BLOCK)
        smask = kpos <= t[:, None, None]
        ss = jnp.einsum('bghqd,bgqkld->bghqkl', qb, ksel).astype(jnp.float32) * scale
        ss = jnp.where(smask[:, :, None], ss, NEG).reshape(B, G, HPG, Q_BLOCK, -1)
        ps = jax.nn.softmax(ss, -1).reshape(B, G, HPG, Q_BLOCK, k_top, SEL_BLOCK)
        o_s = jnp.einsum('bghqkl,bgqkld->bghqd', ps.astype(vsel.dtype), vsel)
        start = qi * Q_BLOCK
        kw = lax.dynamic_slice_in_dim(kw_pad, start, Q_BLOCK + WINDOW, axis=1)
        vw = lax.dynamic_slice_in_dim(vw_pad, start, Q_BLOCK + WINDOW, axis=1)
        spos = start - WINDOW + jnp.arange(Q_BLOCK + WINDOW)
        wmask = (spos[None] <= t[:, None]) & (t[:, None] - spos[None] < WINDOW) & (spos[None] >= 0)
        sw = jnp.einsum('bghqd,bsgd->bghqs', qb, kw).astype(jnp.float32) * scale
        pw = jax.nn.softmax(jnp.where(wmask, sw, NEG), -1)
        o_w = jnp.einsum('bghqs,bsgd->bghqd', pw.astype(vw.dtype), vw)
        return o_s, o_w

    o_slc, o_win = lax.map(block_attn, (jnp.arange(n_q), q_blocks, idx_blocks))
    o_cmp = o_cmp.transpose(0, 3, 1, 2, 4).reshape(B, T, H, N)
    o_slc = o_slc.transpose(1, 0, 4, 2, 3, 5).reshape(B, T, H, N)
    o_win = o_win.transpose(1, 0, 4, 2, 3, 5).reshape(B, T, H, N)
    gate = jax.nn.sigmoid(gate).reshape(B, T, H, 3)
    o = gate[..., 0:1] * o_cmp + gate[..., 1:2] * o_slc + gate[..., 2:3] * o_win
    return o.reshape(B, T, D_NSA).astype(u.dtype)


def setup_inputs(seed: int = 0) -> dict:
    key = jax.random.key(seed)
    keys = iter(jax.random.split(key, 40))
    nrm = lambda shape, s: jax.random.normal(next(keys), shape, jnp.float32) * s
    unif = lambda shape, lo, hi: jax.random.uniform(next(keys), shape, jnp.float32, lo, hi)
    L, D = DEPTH, D_MODEL
    return {
        "x": nrm((BATCH, SEQ, D), 1.0),
        "c": nrm((BATCH, D), 1.0),
        "w_ada": nrm((L, D, 6 * D), 0.2 * D ** -0.5),
        "b_ada": nrm((L, 6 * D), 0.02),
        "w_in": nrm((L, D, IN_COLS), D ** -0.5),
        "rwkv_mu": unif((L, RWKV_COLS), 0.0, 1.0),
        "rwkv_w0": unif((L, D_RWKV), -6.5, -1.5),
        "rwkv_w2": nrm((L, DECAY_LORA, D_RWKV), 0.5 * DECAY_LORA ** -0.5),
        "rwkv_a0": nrm((L, D_RWKV), 0.1),
        "rwkv_a2": nrm((L, AAA_LORA, D_RWKV), 0.5 * AAA_LORA ** -0.5),
        "rwkv_g2": nrm((L, GATE_LORA, D_RWKV), GATE_LORA ** -0.5),
        "rwkv_k_k": 0.85 + nrm((L, D_RWKV), 0.05),
        "rwkv_k_a": 1.0 + nrm((L, D_RWKV), 0.05),
        "rwkv_r_k": nrm((L, RWKV_HEADS, HEAD_DIM), 0.1),
        "rwkv_lnx_g": 1.0 + nrm((L, D_RWKV), 0.05),
        "rwkv_lnx_b": nrm((L, D_RWKV), 0.02),
        "rwkv_v0": nrm((L - 1, D_RWKV), 0.1),
        "rwkv_v1": nrm((L - 1, D_RWKV, MV_LORA), D_RWKV ** -0.5),
        "rwkv_v2": nrm((L - 1, MV_LORA, D_RWKV), 0.5 * MV_LORA ** -0.5),
        "nsa_cmp_pos": nrm((L, 2, CMP_BLOCK, HEAD_DIM), 0.1),
        "nsa_cmp_w1": nrm((L, 2, CMP_BLOCK * HEAD_DIM, CMP_HIDDEN), (CMP_BLOCK * HEAD_DIM) ** -0.5),
        "nsa_cmp_w2": nrm((L, 2, CMP_HIDDEN, HEAD_DIM), CMP_HIDDEN ** -0.5),
        "w_out": nrm((L, D_MIX, D), DN_BETA * D_MIX ** -0.5),
        "ln1_g": 1.0 + nrm((L, D), 0.05),
        "ln1_b": nrm((L, D), 0.02),
        "mlp_w1": nrm((L, D, D_FF), D ** -0.5),
        "mlp_w2": nrm((L, D_FF, D), DN_BETA * D_FF ** -0.5),
        "ln2_g": 1.0 + nrm((L, D), 0.05),
        "ln2_b": nrm((L, D), 0.02),
    }


def reference(x, c, w_ada, b_ada, w_in, rwkv_mu, rwkv_w0, rwkv_w2, rwkv_a0, rwkv_a2, rwkv_g2,
              rwkv_k_k, rwkv_k_a, rwkv_r_k, rwkv_lnx_g, rwkv_lnx_b, rwkv_v0, rwkv_v1, rwkv_v2,
              nsa_cmp_pos, nsa_cmp_w1, nsa_cmp_w2, w_out, ln1_g, ln1_b, mlp_w1, mlp_w2, ln2_g, ln2_b):
    cond = jax.nn.silu(c)
    v_first = None
    for i in range(DEPTH):
        mod = cond @ w_ada[i] + b_ada[i]
        sh_m, sc_m, gt_m, sh_f, sc_f, gt_f = [m[:, None, :] for m in jnp.split(mod, 6, axis=-1)]
        h = x * (1 + sc_m) + sh_m
        u = h @ w_in[i]
        v_res = None if i == 0 else (rwkv_v0[i - 1], rwkv_v1[i - 1], rwkv_v2[i - 1])
        o_rwkv, v_first = _rwkv7_mix(u[..., :RWKV_COLS], v_first, rwkv_mu[i], rwkv_w0[i], rwkv_w2[i],
                                     rwkv_a0[i], rwkv_a2[i], rwkv_g2[i], rwkv_k_k[i], rwkv_k_a[i],
                                     rwkv_r_k[i], rwkv_lnx_g[i], rwkv_lnx_b[i], v_res)
        o_nsa = _nsa_mix(u[..., RWKV_COLS:], nsa_cmp_pos[i], nsa_cmp_w1[i], nsa_cmp_w2[i])
        y = jnp.concatenate([o_rwkv, o_nsa], axis=-1) @ w_out[i]
        x = _layer_norm(DN_ALPHA * x + (1 + gt_m) * y, ln1_g[i], ln1_b[i])
        h = x * (1 + sc_f) + sh_f
        y = jnp.square(jax.nn.relu(h @ mlp_w1[i])) @ mlp_w2[i]
        x = _layer_norm(DN_ALPHA * x + (1 + gt_f) * y, ln2_g[i], ln2_b[i])
    return x
```

```cpp
#include <hip/hip_runtime.h>
#include <cstdio>
#include <cstdint>

#ifndef MK_PER_PHASE
#define MK_PER_PHASE 0
#endif

namespace pg8 {
#define PG8_LAS __attribute__((address_space(3)))
typedef unsigned short bf16_t;
typedef short bf16x8 __attribute__((ext_vector_type(8)));
typedef float f32x4 __attribute__((ext_vector_type(4)));
typedef unsigned u32x4 __attribute__((ext_vector_type(4)));
typedef unsigned u32x2 __attribute__((ext_vector_type(2)));
constexpr int BM = 256, BK = 64, HALF = 128, HTB = HALF * BK * 2  , STAGE_BYTES = 8 * HTB, NXCD = 8, WGM = 8;

__host__ __device__ __forceinline__ int lds_byte(int r, int c) { const int st = (r >> 4) * 2 + (c >> 5), rr = r & 15, cc = c & 31, ob = rr * 64 + cc * 2; return st * 1024 + (ob ^ (((ob >> 9) & 1) << 5)); }
__host__ __device__ __forceinline__ void stage_rc(int b, int& R, int& C) { const int st = b / 1024, sb = b % 1024, swz = sb ^ (((sb >> 9) & 1) << 5); R = (st >> 1) * 16 + swz / 64; C = (st & 1) * 32 + (swz % 64) / 2; }
__host__ __device__ __forceinline__ int perm32(int rho) { const int n = rho >> 4, i = rho & 15; return 8 * (i >> 2) + 4 * n + (i & 3); }

struct Unit { int pm, pn; };
struct Gemm { const bf16_t* A; const bf16_t* Bt; int K, lda, ldb; };

struct StaticOrder {
    int nM, nN, nwg, G, c;
    __host__ __device__ void init(int M, int N, int G_, int c_) { nM = M / BM; nN = N / BM; nwg = nM * nN; G = G_; c = c_; }
    __host__ __device__ bool next(int i, Unit& u) const {
        const long L = (long)i * G + c; if (L >= nwg) return false;
        int wgid = (int)L; { const int q = nwg / NXCD, r = nwg % NXCD, xcd = wgid % NXCD, off = wgid / NXCD; wgid = (xcd < r ? xcd * (q + 1) : r * (q + 1) + (xcd - r) * q) + off; }
        const int nig = WGM * nN, gid = wgid / nig, fm = gid * WGM, gsz = (nM - fm) < WGM ? (nM - fm) : WGM;
        u.pm = fm + ((wgid % nig) % gsz); u.pn = (wgid % nig) / gsz; return true;
    }
    __device__ __forceinline__ void a_ready(const Unit&) const {}
    __device__ __forceinline__ void done(const Unit&) const {}
};
struct ListOrder {
    int n, G, c, kind;
    __device__ bool next(int i, Unit& u) const {
        const int L = i * G + c; if (L >= n) return false;
        if (kind == 0) { const int s = L >> 7, r = L & 127; u.pm = s * 32 + (r & 31); u.pn = s * 4 + (r >> 5); }
        else if (kind == 1) { u.pm = L; u.pn = 0; }
        else if (kind == 2) { u.pm = L; u.pn = L >> 3; }
        else { u.pm = L & 31; u.pn = L >> 5; }
        return true;
    }
    __device__ __forceinline__ void a_ready(const Unit&) const {}
    __device__ __forceinline__ void done(const Unit&) const {}
};

__device__ __forceinline__ unsigned cvt_pk_bf16(float lo, float hi) { unsigned r; asm volatile("v_cvt_pk_bf16_f32 %0, %1, %2" : "=v"(r) : "v"(lo), "v"(hi)); return r; }

template <class F> struct EpiF4 {
    static constexpr bool PERM = false, AFTER_DRAIN = false; F f;
    __device__ __forceinline__ void operator()(const f32x4 (&acc)[2][2][4][2], const Unit& u, int wr, int wc, int fr, int fq) const {
#pragma unroll
        for (int ai = 0; ai < 2; ++ai)
#pragma unroll
            for (int m = 0; m < 4; ++m) { const int row = u.pm * BM + ai * HALF + wr * 64 + m * 16 + fr;
#pragma unroll
                for (int bj = 0; bj < 2; ++bj)
#pragma unroll
                    for (int n = 0; n < 2; ++n) { f(u, row, u.pn * BM + bj * HALF + wc * 32 + 16 * n + 4 * fq, acc[ai][bj][m][n]); asm volatile("" ::: "memory"); } }
    }
};
template <class F> struct EpiF8 {
    static constexpr bool PERM = true, AFTER_DRAIN = false; F f;
    __device__ __forceinline__ void operator()(const f32x4 (&acc)[2][2][4][2], const Unit& u, int wr, int wc, int fr, int fq) const {
#pragma unroll
        for (int ai = 0; ai < 2; ++ai)
#pragma unroll
            for (int m = 0; m < 4; ++m) { const int row = u.pm * BM + ai * HALF + wr * 64 + m * 16 + fr;
#pragma unroll
                for (int bj = 0; bj < 2; ++bj) f(u, row, u.pn * BM + bj * HALF + wc * 32 + 8 * fq, acc[ai][bj][m][0], acc[ai][bj][m][1]);
                asm volatile("" ::: "memory"); }
    }
};

template <class Epi, class Sched, bool ALIGN_EPI = false, bool SP2 = false>
__device__ __forceinline__ void gemm_phase(PG8_LAS unsigned char* lds, const Gemm g, const Sched& S, const Epi& E) {
    int tid_ = threadIdx.x; asm volatile("" : "+v"(tid_));
    const int tid = tid_, wid = __builtin_amdgcn_readfirstlane(tid >> 6), lane = tid & 63, wr = wid >> 2, wc = wid & 3, fr = lane & 15, fq = lane >> 4;
    int Kop = g.K; asm volatile("" : "+s"(Kop));
    const int K = Kop, nt = K / BK;
    unsigned voffA[2], voffB[2];
#pragma unroll
    for (int i = 0; i < 2; ++i) { int R, C; stage_rc(tid * 16 + i * 8192, R, C); const int Rb = Epi::PERM ? ((R & ~31) + perm32(R & 31)) : R;
        voffA[i] = (unsigned)(R * g.lda + C) * 2u; voffB[i] = (unsigned)(Rb * g.ldb + C) * 2u; }
    const size_t kstep = (size_t)(BK * 2);
    const size_t hstepA = (size_t)HALF * g.lda * 2, hstepB = (size_t)HALF * g.ldb * 2;
    const size_t tstepA = 2 * hstepA, tstepB = 2 * hstepB;
    const unsigned ldsw = (unsigned)wid * 1024u;
    const int aoff = lds_byte(wr * 64 + fr, fq * 8), boff = lds_byte(wc * 32 + fr, fq * 8);
#define PG8_SA(b, h) (((b) * 2 + (h)) * HTB)
#define PG8_SB(b, h) ((4 + (b) * 2 + (h)) * HTB)
#define PG8_STAGE(bufoff, gbase, voff) do { _Pragma("unroll") for (int _i = 0; _i < 2; ++_i) \
        __builtin_amdgcn_global_load_lds((const unsigned*)((const char*)(gbase) + (voff)[_i]), (PG8_LAS unsigned*)(lds + (bufoff) + ldsw + _i * 8192), 16, 0, 0); } while (0)
#define PG8_LDA(dst, b, h) do { _Pragma("unroll") for (int m = 0; m < 4; ++m) _Pragma("unroll") for (int k = 0; k < 2; ++k) dst[m][k] = *(const PG8_LAS bf16x8*)(lds + PG8_SA(b, h) + aoff + m * 2048 + k * 1024); } while (0)
#define PG8_LDB(dst, b, h) do { _Pragma("unroll") for (int n = 0; n < 2; ++n) _Pragma("unroll") for (int k = 0; k < 2; ++k) dst[n][k] = *(const PG8_LAS bf16x8*)(lds + PG8_SB(b, h) + boff + n * 2048 + k * 1024); } while (0)
#define PG8_MMA(ai, bj, At, Bt) do { __builtin_amdgcn_s_setprio(1); _Pragma("unroll") for (int m = 0; m < 4; ++m) _Pragma("unroll") for (int n = 0; n < 2; ++n) _Pragma("unroll") for (int k = 0; k < 2; ++k) \
        acc[ai][bj][m][n] = __builtin_amdgcn_mfma_f32_16x16x32_bf16(Bt[n][k], At[m][k], acc[ai][bj][m][n], 0, 0, 0); __builtin_amdgcn_s_setprio(0); } while (0)
#define PG8_WAIT_V(n) asm volatile("s_waitcnt vmcnt(" #n ")" ::: "memory")
#define PG8_WAIT_L(n) asm volatile("s_waitcnt lgkmcnt(" #n ")" ::: "memory")
#define PG8_BAR __builtin_amdgcn_s_barrier()
#define PG8_SCHED __builtin_amdgcn_sched_barrier(0)
    Unit cur, nxt; int ui = 0;
    if (!S.next(0, cur)) return;
    f32x4 acc[2][2][4][2];
#pragma unroll
    for (int a = 0; a < 2; ++a)
#pragma unroll
        for (int b = 0; b < 2; ++b)
#pragma unroll
            for (int m = 0; m < 4; ++m)
#pragma unroll
                for (int n = 0; n < 2; ++n) acc[a][b][m][n] = (f32x4){0.f, 0.f, 0.f, 0.f};
    bf16x8 At[4][2], B0[2][2], B1[2][2];
    const char* cA = (const char*)g.A + (size_t)cur.pm * tstepA; const char* cB = (const char*)g.Bt + (size_t)cur.pn * tstepB;
    S.a_ready(cur);
    if constexpr (SP2) {
        PG8_STAGE(PG8_SB(0, 0), cB, voffB); PG8_STAGE(PG8_SB(0, 1), cB + hstepB, voffB); PG8_STAGE(PG8_SA(0, 0), cA, voffA); PG8_STAGE(PG8_SA(0, 1), cA + hstepA, voffA);
        if (wr == 1) PG8_BAR;
        PG8_WAIT_V(2); PG8_BAR;
        PG8_STAGE(PG8_SB(1, 0), cB + kstep, voffB); PG8_STAGE(PG8_SA(1, 0), cA + kstep, voffA); PG8_STAGE(PG8_SB(1, 1), cB + hstepB + kstep, voffB);
        PG8_WAIT_V(6); PG8_BAR;
    } else {
        PG8_STAGE(PG8_SB(0, 0), cB, voffB); PG8_STAGE(PG8_SA(0, 0), cA, voffA); PG8_STAGE(PG8_SB(0, 1), cB + hstepB, voffB); PG8_STAGE(PG8_SA(0, 1), cA + hstepA, voffA);
        if (wr == 1) PG8_BAR;
        PG8_WAIT_V(4); PG8_BAR;
        PG8_STAGE(PG8_SB(1, 0), cB + kstep, voffB); PG8_STAGE(PG8_SA(1, 0), cA + kstep, voffA); PG8_STAGE(PG8_SB(1, 1), cB + hstepB + kstep, voffB);
        PG8_WAIT_V(6); PG8_BAR;
    }
    for (;;) {
        const bool has_next = S.next(ui + 1, nxt);
        const char* nA = has_next ? (const char*)g.A + (size_t)nxt.pm * tstepA : cA; const char* nB = has_next ? (const char*)g.Bt + (size_t)nxt.pn * tstepB : cB;
        for (int t = 0; t < nt; t += 2) {
            const bool last = (t == nt - 2);
            const char* a1 = cA + (size_t)(t + 1) * kstep;
            const char* a2 = last ? nA : cA + (size_t)(t + 2) * kstep; const char* b2 = last ? nB : cB + (size_t)(t + 2) * kstep;
            const char* a3 = a2 + kstep; const char* b3 = b2 + kstep;
            if (last && has_next) S.a_ready(nxt);
            if constexpr (SP2) {
            PG8_LDB(B0, 0, 0); PG8_LDB(B1, 0, 1); PG8_SCHED; PG8_LDA(At, 0, 0); PG8_STAGE(PG8_SA(1, 1), a1 + hstepA, voffA);
            PG8_WAIT_V(8); PG8_WAIT_L(0); PG8_BAR; PG8_MMA(0, 0, At, B0); PG8_MMA(0, 1, At, B1); PG8_BAR; PG8_SCHED;
            PG8_LDA(At, 0, 1); PG8_STAGE(PG8_SB(0, 0), b2, voffB); PG8_STAGE(PG8_SB(0, 1), b2 + hstepB, voffB); PG8_STAGE(PG8_SA(0, 0), a2, voffA);
            PG8_WAIT_V(8); PG8_WAIT_L(0); PG8_BAR; PG8_MMA(1, 0, At, B0); PG8_MMA(1, 1, At, B1); PG8_BAR; PG8_SCHED;
            PG8_LDB(B0, 1, 0); PG8_LDB(B1, 1, 1); PG8_SCHED; PG8_LDA(At, 1, 0); PG8_STAGE(PG8_SA(0, 1), a2 + hstepA, voffA);
            PG8_WAIT_V(8); PG8_WAIT_L(0); PG8_BAR; PG8_MMA(0, 0, At, B0); PG8_MMA(0, 1, At, B1); PG8_BAR; PG8_SCHED;
            PG8_LDA(At, 1, 1); PG8_STAGE(PG8_SB(1, 0), b3, voffB); PG8_STAGE(PG8_SB(1, 1), b3 + hstepB, voffB); PG8_STAGE(PG8_SA(1, 0), a3, voffA);
            PG8_WAIT_V(8); PG8_WAIT_L(0); PG8_BAR; PG8_MMA(1, 0, At, B0); PG8_MMA(1, 1, At, B1); PG8_BAR; PG8_SCHED;
            } else {
            PG8_LDB(B0, 0, 0); PG8_SCHED; PG8_LDA(At, 0, 0); PG8_STAGE(PG8_SA(1, 1), a1 + hstepA, voffA);
            PG8_WAIT_L(8); PG8_BAR; PG8_WAIT_L(0); PG8_MMA(0, 0, At, B0); PG8_BAR; PG8_SCHED;
            PG8_LDB(B1, 0, 1); PG8_STAGE(PG8_SB(0, 0), b2, voffB);
            PG8_BAR; PG8_WAIT_L(0); PG8_MMA(0, 1, At, B1); PG8_BAR;
            PG8_LDA(At, 0, 1); PG8_STAGE(PG8_SA(0, 0), a2, voffA);
            PG8_BAR; PG8_WAIT_L(0); PG8_MMA(1, 0, At, B0); PG8_BAR; PG8_SCHED;
            PG8_STAGE(PG8_SB(0, 1), b2 + hstepB, voffB);
            PG8_WAIT_V(6); PG8_BAR; PG8_MMA(1, 1, At, B1); PG8_BAR;
            PG8_LDB(B0, 1, 0); PG8_SCHED; PG8_LDA(At, 1, 0); PG8_STAGE(PG8_SA(0, 1), a2 + hstepA, voffA);
            PG8_WAIT_L(8); PG8_BAR; PG8_WAIT_L(0); PG8_MMA(0, 0, At, B0); PG8_BAR; PG8_SCHED;
            PG8_LDB(B1, 1, 1); PG8_STAGE(PG8_SB(1, 0), b3, voffB);
            PG8_BAR; PG8_WAIT_L(0); PG8_MMA(0, 1, At, B1); PG8_BAR;
            PG8_LDA(At, 1, 1); PG8_STAGE(PG8_SA(1, 0), a3, voffA);
            PG8_BAR; PG8_WAIT_L(0); PG8_MMA(1, 0, At, B0); PG8_BAR; PG8_SCHED;
            PG8_STAGE(PG8_SB(1, 1), b3 + hstepB, voffB);
            PG8_WAIT_V(6); PG8_BAR; PG8_MMA(1, 1, At, B1); PG8_BAR;
            }
        }
        if constexpr (ALIGN_EPI) { if (wr == 0) PG8_BAR; }
        if constexpr (!Epi::AFTER_DRAIN) { E(acc, cur, wr, wc, fr, fq); S.done(cur); }
        if (!has_next) break;
#pragma unroll
        for (int a = 0; a < 2; ++a)
#pragma unroll
            for (int b = 0; b < 2; ++b)
#pragma unroll
                for (int m = 0; m < 4; ++m)
#pragma unroll
                    for (int n = 0; n < 2; ++n) acc[a][b][m][n] = (f32x4){0.f, 0.f, 0.f, 0.f};
        cur = nxt; cA = nA; cB = nB; ++ui;
        if constexpr (ALIGN_EPI) { if (wr == 1) PG8_BAR; }
    }
    PG8_WAIT_V(0);
    if constexpr (!ALIGN_EPI) { if (wr == 0) PG8_BAR; }
    PG8_BAR;
    if constexpr (Epi::AFTER_DRAIN) { E.fused(acc, cur, wr, wc, fr, fq, lds, wid, lane); S.done(cur); }
#undef PG8_SA
#undef PG8_SB
#undef PG8_STAGE
#undef PG8_LDA
#undef PG8_LDB
#undef PG8_MMA
#undef PG8_WAIT_V
#undef PG8_WAIT_L
#undef PG8_BAR
#undef PG8_SCHED
}
}

constexpr int NWAVES = 8;
constexpr int BATCH = 4, SEQ = 2048, DM = 2048, DEPTH = 4, MTOK = BATCH * SEQ;
constexpr int DR = 1024, DN = 1024, NKV = 256, DFF = 8192;
constexpr int RWKV_COLS = 3520, NSA_COLS = 2608, IN_COLS = 6128, NINP = 6144;
constexpr float LN_EPS = 1e-5f, GN_EPS = 64e-5f;
constexpr float DN_ALPHA = 1.681792830507429f;
constexpr float NEGBIG = -1e30f;
constexpr int N_PHASES = 2 + 13 * DEPTH;

constexpr size_t KiB = 1024, MiB = 1u << 20;
constexpr size_t WS_CTL = 0, CTL_ZERO_BYTES = 1 * MiB;
constexpr int CW_BAR = 4096;
constexpr size_t WS_MOD = 1 * MiB;
constexpr size_t WS_ROPE = WS_MOD + 786432;
constexpr size_t WS_B1 = WS_ROPE + 524288;
constexpr size_t WS_WT = 3 * MiB;
constexpr size_t WL_IN = 0, WL_OUT = WL_IN + (size_t)NINP * DM * 2, WL_W1 = WL_OUT + (size_t)DM * DM * 2, WL_W2 = WL_W1 + (size_t)DFF * DM * 2,
                 WL_LORA = WL_W2 + (size_t)DM * DFF * 2, WL_V1 = WL_LORA + (size_t)3072 * 256 * 2, WL_V2 = WL_V1 + (size_t)256 * 1024 * 2,
                 WL_C1 = WL_V2 + (size_t)1024 * 256 * 2, WL_C2 = WL_C1 + (size_t)512 * 2048 * 2, WL_STRIDE = WL_C2 + (size_t)512 * 256 * 2;
constexpr size_t ACT_F32 = (size_t)MTOK * DM * 4;
constexpr size_t R1024_F32 = (size_t)MTOK * 1024 * 4;
constexpr size_t WS_XA = WS_WT + 4 * WL_STRIDE + 1 * MiB;
constexpr size_t WS_XB = WS_XA + ACT_F32, WS_Z = WS_XB + ACT_F32, WS_H = WS_Z + ACT_F32;
constexpr size_t WS_U = WS_H + (size_t)MTOK * DM * 2;
constexpr size_t WS_LA = WS_U + (size_t)MTOK * NINP * 4;
constexpr size_t WS_VB = WS_LA + (size_t)3 * MTOK * 256 * 2;
constexpr size_t WS_V1O = WS_VB + (size_t)MTOK * 1024 * 2;
constexpr size_t WS_VF = WS_V1O + (size_t)MTOK * 256 * 2;
constexpr size_t WS_V = WS_VF + R1024_F32, WS_WD = WS_V + R1024_F32, WS_AA = WS_WD + R1024_F32, WS_GG = WS_AA + R1024_F32, WS_RR = WS_GG + R1024_F32,
                 WS_KK = WS_RR + R1024_F32, WS_KM = WS_KK + R1024_F32, WS_BV = WS_KM + R1024_F32, WS_OS = WS_BV + R1024_F32,
                 WS_OCMP = WS_OS + R1024_F32, WS_OSLC = WS_OCMP + R1024_F32, WS_OWIN = WS_OSLC + R1024_F32, WS_BONUS = WS_OWIN + R1024_F32;
constexpr size_t WS_QN = WS_BONUS + (size_t)MTOK * 16 * 4;
constexpr size_t WS_KCH = WS_QN + (size_t)MTOK * 1024 * 2;
constexpr size_t WS_VCH = WS_KCH + (size_t)16 * 2048 * 64 * 2;
constexpr size_t WS_KS = WS_VCH + (size_t)16 * 2048 * 64 * 2 + 4096;
constexpr size_t WS_KW = WS_KS + (size_t)16 * 2048 * 64 * 2, WS_VST = WS_KW + (size_t)16 * 2048 * 64 * 2, WS_VWT = WS_VST + (size_t)16 * 2048 * 64 * 2;
constexpr size_t WS_GATE = WS_VWT + (size_t)16 * 2048 * 64 * 2;
constexpr size_t WS_CH = WS_GATE + (size_t)MTOK * 48 * 4;
constexpr size_t WS_KC = WS_CH + (size_t)4096 * 256 * 2;
constexpr size_t WS_VCT = WS_KC + (size_t)16 * 128 * 64 * 2;
constexpr size_t WS_MIX = WS_VCT + (size_t)16 * 64 * 128 * 2;
constexpr size_t WS_END = WS_MIX + (size_t)MTOK * DM * 2;
static_assert((size_t)MTOK * DFF * 2 <= (size_t)MTOK * NINP * 4, "HID overlays U");
static_assert(WS_END < (size_t)1560 * MiB, "workspace map too large");

constexpr int RING_BYTES = 131072;
constexpr int LDSCTL_OFF = RING_BYTES, MISC_OFF = LDSCTL_OFF + 320;
constexpr int LDS_BYTES = 147456;

#define GAS __attribute__((address_space(1)))
#define LAS __attribute__((address_space(3)))
typedef unsigned short bf16;
typedef unsigned v4u __attribute__((ext_vector_type(4)));
typedef unsigned v2u __attribute__((ext_vector_type(2)));
typedef float f32x4 __attribute__((ext_vector_type(4)));
typedef float f32x2 __attribute__((ext_vector_type(2)));
typedef short bf16x8 __attribute__((ext_vector_type(8)));
typedef short bf16x4 __attribute__((ext_vector_type(4)));
typedef GAS unsigned gu32;
#define RLX_AGENT __ATOMIC_RELAXED, __HIP_MEMORY_SCOPE_AGENT
#define LDS_WAIT() asm volatile("s_waitcnt lgkmcnt(0)" ::: "memory")
#define VM_WAIT() asm volatile("s_waitcnt vmcnt(0)" ::: "memory")
__device__ __forceinline__ unsigned pk2(float lo, float hi) { return pg8::cvt_pk_bf16(lo, hi); }
__device__ __forceinline__ float bf2f(unsigned short b) { return __uint_as_float((unsigned)b << 16); }
__device__ __forceinline__ float sigmoidf_(float x) { return 1.0f / (1.0f + __expf(-x)); }
__device__ __forceinline__ float wave_sum(float v) {
#pragma unroll
    for (int o = 1; o < 64; o <<= 1) v += __shfl_xor(v, o);
    return v;
}
template <int CTRL> __device__ __forceinline__ float dppf(float x) { return __int_as_float(__builtin_amdgcn_mov_dpp(__float_as_int(x), CTRL, 0xF, 0xF, true)); }
__device__ __forceinline__ float row16_sum(float x) { x += dppf<0xB1>(x); x += dppf<0x4E>(x); x += dppf<0x141>(x); x += dppf<0x140>(x); return x; }
__device__ __forceinline__ float quad_sum(float x) { x += dppf<0xB1>(x); x += dppf<0x4E>(x); return x; }

#define XB_TMO      128
#define XB_XCNT(j)  (256  + 64 * (j))
#define XB_XSUB(j)  (1280 + 64 * (j))
#define XB_XGEN(j)  (2304 + 64 * (j))
#define XB_TOP      3328
#define XB_TOPGEN   3392
#define XCD_BAR_WORDS 3456
#define XB_SPIN_CAP (1u << 18)

__device__ __forceinline__ unsigned xb_ld(unsigned* p)              { return __hip_atomic_load(p, __ATOMIC_RELAXED, __HIP_MEMORY_SCOPE_AGENT); }
__device__ __forceinline__ unsigned xb_add(unsigned* p, unsigned v) { return __hip_atomic_fetch_add(p, v, __ATOMIC_RELAXED, __HIP_MEMORY_SCOPE_AGENT); }
__device__ __forceinline__ unsigned xb_xcc_id() { return (unsigned)__builtin_amdgcn_s_getreg((3 << 11) | 20) & 0xFu; }
#define XB_SPIN(cond, bar) do { unsigned _sp = 0; while (cond) { __builtin_amdgcn_s_sleep(1); \
    if ((++_sp & 255u) == 0u) { if (xb_ld(&(bar)[XB_TMO])) break; if (_sp > XB_SPIN_CAP) { atomicAdd(&(bar)[XB_TMO], 1u); break; } } } } while (0)

struct XcdBarrier {
    unsigned* bar; unsigned x;
    volatile LAS unsigned* st;
};

__device__ __forceinline__ XcdBarrier xcd_barrier_post(unsigned* bar, volatile LAS unsigned* st) {
    XcdBarrier b; b.bar = bar; b.x = xb_xcc_id(); b.st = st;
    if (threadIdx.x == 0) (void)xb_add(&bar[XB_XCNT(b.x)], 1u);
    return b;
}
__device__ __forceinline__ void xcd_barrier_complete(unsigned* bar, unsigned x, unsigned& nloc, unsigned& nx) {
    const unsigned G = gridDim.x * gridDim.y * gridDim.z;
    unsigned sum, cnt, mine, sp = 0u;
    for (;;) {
        sum = 0u; cnt = 0u; mine = 0u;
#pragma unroll
        for (unsigned j = 0; j < 16; ++j) { const unsigned c = xb_ld(&bar[XB_XCNT(j)]); sum += c; cnt += (c > 0u) ? 1u : 0u; mine = (j == x) ? c : mine; }
        if (sum == G) break;
        __builtin_amdgcn_s_sleep(1);
        if ((++sp & 255u) == 0u) { if (xb_ld(&bar[XB_TMO])) break; if (sp > XB_SPIN_CAP) { atomicAdd(&bar[XB_TMO], 1u); break; } }
    }
    nloc = mine > 0u ? mine : 1u; nx = cnt > 0u ? cnt : 1u;
}

__device__ __forceinline__ void xcd_barrier(const XcdBarrier& b) {
    asm volatile("s_waitcnt vmcnt(0)" ::: "memory");
    __syncthreads();
    if (threadIdx.x == 0) {
        unsigned* bar = b.bar;
        __builtin_amdgcn_s_waitcnt(0);
        unsigned nloc = b.st[0], nx = b.st[1];
        if (nloc == 0u) { xcd_barrier_complete(bar, b.x, nloc, nx); b.st[0] = nloc; b.st[1] = nx; }
        const unsigned old = xb_add(&bar[XB_XSUB(b.x)], 1u);
        const unsigned gen = old / nloc;
        if (old + 1u == (gen + 1u) * nloc) {
            __builtin_amdgcn_fence(__ATOMIC_RELEASE, "agent");
            asm volatile("s_waitcnt vmcnt(0)" ::: "memory");
            const unsigned og = xb_add(&bar[XB_TOP], 1u);
            const unsigned tg = og / nx;
            if (og + 1u == (tg + 1u) * nx) xb_add(&bar[XB_TOPGEN], 1u);
            else XB_SPIN(xb_ld(&bar[XB_TOPGEN]) == tg, bar);
            __builtin_amdgcn_fence(__ATOMIC_ACQUIRE, "agent");
            xb_add(&bar[XB_XGEN(b.x)], 1u);
            asm volatile("s_waitcnt vmcnt(0)" ::: "memory");
        } else {
            XB_SPIN(xb_ld(&bar[XB_XGEN(b.x)]) == gen, bar);
            __builtin_amdgcn_fence(__ATOMIC_ACQUIRE, "agent");
            asm volatile("s_waitcnt vmcnt(0)" ::: "memory");
        }
    }
    __syncthreads();
}

struct Args { const float* in[29]; float* out; unsigned char* ws; int ph_lo, ph_hi; };
struct Frame {
    LAS unsigned char* lds;
    volatile LAS unsigned* MISC;
    gu32* ctl;
    int tid, lane, wave, vcu, G;
    unsigned char* ws;
};
__device__ __forceinline__ const float* modp(const Frame& F, int l, int b, int which) { return (const float*)(F.ws + WS_MOD) + ((size_t)(l * 4 + b) * 12288 + which * 2048); }
__device__ __forceinline__ unsigned char* wlayer(const Frame& F, int l) { return F.ws + WS_WT + (size_t)l * WL_STRIDE; }

struct CDesc { const float* src; bf16* dst; int ldw, Kv, Nv, Kp, Np; };
__device__ __forceinline__ bool conv_desc(const Args& a, const Frame& F, int l, int kind, CDesc& d) {
    unsigned char* wl = wlayer(F, l);
    switch (kind) {
    case 0: d.src = a.in[4] + (size_t)l * 2048 * 6128; d.dst = (bf16*)(wl + WL_IN); d.ldw = 6128; d.Kv = 2048; d.Nv = 6128; d.Kp = 2048; d.Np = 6144; return true;
    case 1: d.src = a.in[22] + (size_t)l * 2048 * 2048; d.dst = (bf16*)(wl + WL_OUT); d.ldw = 2048; d.Kv = 2048; d.Nv = 2048; d.Kp = 2048; d.Np = 2048; return true;
    case 2: d.src = a.in[25] + (size_t)l * 2048 * 8192; d.dst = (bf16*)(wl + WL_W1); d.ldw = 8192; d.Kv = 2048; d.Nv = 8192; d.Kp = 2048; d.Np = 8192; return true;
    case 3: d.src = a.in[26] + (size_t)l * 8192 * 2048; d.dst = (bf16*)(wl + WL_W2); d.ldw = 2048; d.Kv = 8192; d.Nv = 2048; d.Kp = 8192; d.Np = 2048; return true;
    case 4: d.src = a.in[7] + (size_t)l * 96 * 1024; d.dst = (bf16*)(wl + WL_LORA); d.ldw = 1024; d.Kv = 96; d.Nv = 1024; d.Kp = 256; d.Np = 1024; return true;
    case 5: d.src = a.in[9] + (size_t)l * 96 * 1024; d.dst = (bf16*)(wl + WL_LORA) + (size_t)1024 * 256; d.ldw = 1024; d.Kv = 96; d.Nv = 1024; d.Kp = 256; d.Np = 1024; return true;
    case 6: d.src = a.in[10] + (size_t)l * 256 * 1024; d.dst = (bf16*)(wl + WL_LORA) + (size_t)2048 * 256; d.ldw = 1024; d.Kv = 256; d.Nv = 1024; d.Kp = 256; d.Np = 1024; return true;
    case 7: if (l == 0) return false; d.src = a.in[17] + (size_t)(l - 1) * 1024 * 64; d.dst = (bf16*)(wl + WL_V1); d.ldw = 64; d.Kv = 1024; d.Nv = 64; d.Kp = 1024; d.Np = 256; return true;
    case 8: if (l == 0) return false; d.src = a.in[18] + (size_t)(l - 1) * 64 * 1024; d.dst = (bf16*)(wl + WL_V2); d.ldw = 1024; d.Kv = 64; d.Nv = 1024; d.Kp = 256; d.Np = 1024; return true;
    case 9: d.src = a.in[20] + (size_t)(l * 2) * 2048 * 256; d.dst = (bf16*)(wl + WL_C1); d.ldw = 256; d.Kv = 2048; d.Nv = 256; d.Kp = 2048; d.Np = 256; return true;
    case 10: d.src = a.in[20] + (size_t)(l * 2 + 1) * 2048 * 256; d.dst = (bf16*)(wl + WL_C1) + (size_t)256 * 2048; d.ldw = 256; d.Kv = 2048; d.Nv = 256; d.Kp = 2048; d.Np = 256; return true;
    case 11: d.src = a.in[21] + (size_t)(l * 2) * 256 * 64; d.dst = (bf16*)(wl + WL_C2); d.ldw = 64; d.Kv = 256; d.Nv = 64; d.Kp = 256; d.Np = 256; return true;
    default: d.src = a.in[21] + (size_t)(l * 2 + 1) * 256 * 64; d.dst = (bf16*)(wl + WL_C2) + (size_t)256 * 256; d.ldw = 64; d.Kv = 256; d.Nv = 64; d.Kp = 256; d.Np = 256; return true;
    }
}
__device__ __forceinline__ void transpose_item(const CDesc& d, LAS float* scr, int item, int lane) {
    const int nblk = d.Np / 32, kb = item / nblk, nb = item % nblk, k0 = 64 * kb, n0 = 32 * nb;
    const int n = n0 + (lane & 31); const bool nok = n < d.Nv;
#pragma unroll 8
    for (int i = 0; i < 32; ++i) { const int kk = 2 * i + (lane >> 5); const int k = k0 + kk;
        float v = 0.f; if (nok && k < d.Kv) v = d.src[(size_t)k * d.ldw + n];
        scr[kk * 33 + (lane & 31)] = v; }
    LDS_WAIT(); asm volatile("" ::: "memory");
    const int c = lane & 7;
#pragma unroll
    for (int j = 0; j < 4; ++j) { const int nn = (lane >> 3) + 8 * j; const LAS float* s = scr + (8 * c) * 33 + nn;
        v4u o; o.x = pk2(s[0 * 33], s[1 * 33]); o.y = pk2(s[2 * 33], s[3 * 33]); o.z = pk2(s[4 * 33], s[5 * 33]); o.w = pk2(s[6 * 33], s[7 * 33]);
        *(GAS v4u*)(d.dst + (size_t)(n0 + nn) * d.Kp + k0 + 8 * c) = o; }
    LDS_WAIT(); asm volatile("" ::: "memory");
}
__device__ __forceinline__ void rope_entry(int idx, f32x2* tab) {
    const int t = idx >> 5, i = idx & 31;
    double p = 1.0; for (int n = 0; n < i; ++n) p *= 0.7498942093324559;
    const float invf = (float)p; const float angf = (float)t * invf;
    const double x = (double)angf; const double kd = __builtin_rint(x * 0.6366197723675814); const int q = (int)kd;
    double r = __builtin_fma(-kd, 1.5707963267948966, x); r = __builtin_fma(-kd, 6.123233995736766e-17, r);
    const double r2 = r * r;
    const double s = r * (1.0 + r2 * (-1.0 / 6.0 + r2 * (1.0 / 120.0 + r2 * (-1.0 / 5040.0 + r2 * (1.0 / 362880.0 + r2 * (-1.0 / 39916800.0 + r2 * (1.0 / 6227020800.0 + r2 * (-1.0 / 1307674368000.0))))))));
    const double c = 1.0 + r2 * (-0.5 + r2 * (1.0 / 24.0 + r2 * (-1.0 / 720.0 + r2 * (1.0 / 40320.0 + r2 * (-1.0 / 3628800.0 + r2 * (1.0 / 479001600.0 + r2 * (-1.0 / 87178291200.0 + r2 * (1.0 / 20922789888000.0))))))));
    double cs, sn; const int qq = q & 3;
    if (qq == 0) { cs = c; sn = s; } else if (qq == 1) { cs = -s; sn = c; } else if (qq == 2) { cs = -c; sn = -s; } else { cs = s; sn = -c; }
    tab[idx] = (f32x2){(float)cs, (float)sn};
}
__device__ __forceinline__ void phase_pre0(Frame& F, const Args& a) {
    LAS float* condT = (LAS float*)(F.lds);
    LAS float* part = (LAS float*)(F.lds + 32768);
    LAS float* pv = (LAS float*)(F.lds + 40960);
    { const float* c = a.in[1];
      for (int i = F.tid; i < 8192; i += 512) { const int k = i >> 2, b = i & 3; const float x = c[b * 2048 + k]; condT[i] = x / (1.f + __expf(-x)); }
      __syncthreads();
      float* mod = (float*)(F.ws + WS_MOD);
      for (int it = blockIdx.x; it < 768; it += F.G) {
          const int l = it / 192, n0 = (it % 192) * 64;
          const float* W = a.in[2] + (size_t)l * 2048 * 12288 + n0 + F.lane;
          float a0 = 0.f, a1 = 0.f, a2 = 0.f, a3 = 0.f; const int k0 = F.wave * 256;
#pragma unroll 8
          for (int kk = 0; kk < 256; ++kk) { const int k = k0 + kk; const float wv = W[(size_t)k * 12288]; const f32x4 cv = *(const LAS f32x4*)(condT + 4 * k);
              a0 += cv.x * wv; a1 += cv.y * wv; a2 += cv.z * wv; a3 += cv.w * wv; }
          part[(F.wave * 4 + 0) * 64 + F.lane] = a0; part[(F.wave * 4 + 1) * 64 + F.lane] = a1; part[(F.wave * 4 + 2) * 64 + F.lane] = a2; part[(F.wave * 4 + 3) * 64 + F.lane] = a3;
          __syncthreads();
          if (F.tid < 256) { const int b = F.tid >> 6, n = F.tid & 63; float s = 0.f;
#pragma unroll
              for (int w = 0; w < 8; ++w) s += part[(w * 4 + b) * 64 + n];
              mod[(size_t)(l * 4 + b) * 12288 + n0 + n] = s + a.in[3][l * 12288 + n0 + n]; }
          __syncthreads();
      } }
    { float* B1 = (float*)(F.ws + WS_B1);
      for (int it = (int)blockIdx.x - 64; it < 32; it += F.G) {
          if (it < 0) continue;
          const int l = it >> 3, j = (it >> 2) & 1, cg = it & 3;
          const float* pos = a.in[19] + (size_t)(l * 2 + j) * 2048;
          for (int i = F.tid; i < 2048; i += 512) pv[i] = pos[i];
          __syncthreads();
          const float* W = a.in[20] + (size_t)(l * 2 + j) * 2048 * 256 + cg * 64 + F.lane;
          float acc = 0.f; const int k0 = F.wave * 256;
#pragma unroll 8
          for (int kk = 0; kk < 256; ++kk) acc += pv[k0 + kk] * W[(size_t)(k0 + kk) * 256];
          part[F.wave * 64 + F.lane] = acc;
          __syncthreads();
          if (F.tid < 64) { float s = 0.f;
#pragma unroll
              for (int w = 0; w < 8; ++w) s += part[w * 64 + F.tid];
              B1[(l * 2 + j) * 256 + cg * 64 + F.tid] = s; }
          __syncthreads();
      } }
    { f32x2* tab = (f32x2*)(F.ws + WS_ROPE);
      for (int idx = blockIdx.x * 512 + F.tid; idx < 2048 * 32; idx += F.G * 512) rope_entry(idx, tab); }
    { __syncthreads();
      LAS float* scr = (LAS float*)(F.lds + F.wave * 16384);
      const int gw = F.vcu * NWAVES + F.wave, NGW = F.G * NWAVES; int off = 0;
      for (int l = 0; l < DEPTH; ++l)
          for (int kind = 0; kind < 13; ++kind) {
              CDesc d; if (!conv_desc(a, F, l, kind, d)) continue;
              const int nitems = (d.Kp / 64) * (d.Np / 32);
              int start = gw - (off % NGW); if (start < 0) start += NGW;
              for (int it = start; it < nitems; it += NGW) transpose_item(d, scr, it, F.lane);
              off += nitems;
          }
      __syncthreads(); }
}
__device__ __forceinline__ void phase_pre1(Frame& F, const Args& a) {
    const int gw = F.vcu * NWAVES + F.wave, NGW = F.G * NWAVES;
    bf16* H = (bf16*)(F.ws + WS_H);
    for (int m = gw; m < MTOK; m += NGW) {
        const int b = m >> 11; const float* xr = a.in[0] + (size_t)m * DM; const float* sh = modp(F, 0, b, 0); const float* sc = modp(F, 0, b, 1);
#pragma unroll
        for (int j = 0; j < 8; ++j) { const int col = 4 * (F.lane + 64 * j);
            const f32x4 xv = *(const f32x4*)(xr + col), s4 = *(const f32x4*)(sc + col), h4 = *(const f32x4*)(sh + col);
            const f32x4 h = xv * (s4 + 1.0f) + h4; v2u o; o.x = pk2(h.x, h.y); o.y = pk2(h.z, h.w);
            *(v2u*)(H + (size_t)m * DM + col) = o; }
    }
}
__device__ __forceinline__ void phase_prep(Frame& F, const Args& a, int l) {
    LAS bf16* stT = (LAS bf16*)(F.lds);
    const float* U = (const float*)(F.ws + WS_U); const float* mu = a.in[5] + (size_t)l * RWKV_COLS;
    const f32x2* rope = (const f32x2*)(F.ws + WS_ROPE);
    bf16* LA = (bf16*)(F.ws + WS_LA); float* V0 = (float*)(F.ws + (l == 0 ? WS_VF : WS_V)); bf16* VB = (bf16*)(F.ws + WS_VB);
    bf16* QN = (bf16*)(F.ws + WS_QN); bf16* KCH = (bf16*)(F.ws + WS_KCH); bf16* VCH = (bf16*)(F.ws + WS_VCH); bf16* KS = (bf16*)(F.ws + WS_KS); bf16* KW = (bf16*)(F.ws + WS_KW);
    bf16* VST = (bf16*)(F.ws + WS_VST); bf16* VWT = (bf16*)(F.ws + WS_VWT); float* GATE = (float*)(F.ws + WS_GATE);
    if (blockIdx.x == 0 && F.tid < 256) *(v4u*)(F.ws + WS_VCH + (size_t)16 * 2048 * 64 * 2 + F.tid * 16) = (v4u){0u, 0u, 0u, 0u};
    const int lane = F.lane;
    for (int item = blockIdx.x; item < MTOK / 32; item += F.G) {
        const int m0 = item * 32, b = m0 >> 11, tbase = m0 & 2047;
        for (int tl4 = 0; tl4 < 4; ++tl4) {
            const int tl = F.wave * 4 + tl4, m = m0 + tl, t = tbase + tl;
            const float* ur = U + (size_t)m * NINP; const bool hasprev = t > 0;
            for (int s = 8; s < 24; ++s) {
                const int col = s * 256 + 4 * lane;
                f32x4 v = *(const f32x4*)(ur + col);
                if (col < RWKV_COLS) { f32x4 pvv = (f32x4){0.f, 0.f, 0.f, 0.f}; if (hasprev) pvv = *(const f32x4*)(ur - NINP + col);
                    const f32x4 m4 = *(const f32x4*)(mu + col); v = v + (pvv - v) * m4; }
                f32x4 o = v;
                if (s >= 13) {
                    f32x4 pr; pr.x = __shfl_xor(v.x, 8); pr.y = __shfl_xor(v.y, 8); pr.z = __shfl_xor(v.z, 8); pr.w = __shfl_xor(v.w, 8);
                    const int d = col & 63, i0 = d & 31;
                    const f32x4 cs01 = *(const f32x4*)(rope + t * 32 + i0), cs23 = *(const f32x4*)(rope + t * 32 + i0 + 2);
                    const f32x4 cs = (f32x4){cs01.x, cs01.z, cs23.x, cs23.z}, sn = (f32x4){cs01.y, cs01.w, cs23.y, cs23.w};
                    o = (d < 32) ? (v * cs - pr * sn) : (v * cs + pr * sn);
                }
                if (col < 2048 + 1024) {
                    const int c = col - 2048; *(f32x4*)(V0 + (size_t)m * 1024 + c) = v;
                    if (l > 0) { v2u w; w.x = pk2(v.x, v.y); w.y = pk2(v.z, v.w); *(v2u*)(VB + (size_t)m * 1024 + c) = w; }
                } else if (col < 3168) {
                    const int c = col - 3072; v2u w; w.x = pk2(tanhf(v.x), tanhf(v.y)); w.y = pk2(tanhf(v.z), tanhf(v.w)); *(v2u*)(LA + (size_t)m * 256 + c) = w;
                } else if (col < 3264) {
                    const int c = col - 3168; v2u w; w.x = pk2(v.x, v.y); w.y = pk2(v.z, v.w); *(v2u*)(LA + (size_t)(MTOK + m) * 256 + c) = w;
                } else if (col < 3520) {
                    const int c = col - 3264; v2u w; w.x = pk2(sigmoidf_(v.x), sigmoidf_(v.y)); w.y = pk2(sigmoidf_(v.z), sigmoidf_(v.w)); *(v2u*)(LA + (size_t)(2 * MTOK + m) * 256 + c) = w;
                } else {
                    const int ci = col - 3520;
                    if (ci < 1024) { v2u w; w.x = pk2(o.x * 0.125f, o.y * 0.125f); w.y = pk2(o.z * 0.125f, o.w * 0.125f); *(v2u*)(QN + (size_t)m * 1024 + ci) = w; }
                    else if (ci < 2560) {
                        const int r = (ci - 1024) >> 8, cc = (ci - 1024) & 255, g = cc >> 6, d = cc & 63;
                        const size_t hm = ((size_t)((b * 4 + g) * 2048 + t)) * 64 + d;
                        if (r == 0) { v2u w; w.x = pk2(o.x, o.y); w.y = pk2(o.z, o.w); *(v2u*)(KCH + hm) = w; }
                        else if (r == 1) { v2u w; w.x = pk2(v.x, v.y); w.y = pk2(v.z, v.w); *(v2u*)(VCH + hm) = w; }
                        else if (r == 2) { v2u w; w.x = pk2(o.x, o.y); w.y = pk2(o.z, o.w); *(v2u*)(KS + hm) = w; }
                        else if (r == 4) { v2u w; w.x = pk2(o.x, o.y); w.y = pk2(o.z, o.w); *(v2u*)(KW + hm) = w; }
                        else { const int which = (r == 3) ? 0 : 1; LAS bf16* sp = stT + (size_t)(which * 256 + cc) * 40 + tl;
                            const unsigned w0 = pk2(v.x, v.y), w1 = pk2(v.z, v.w);
                            sp[0] = (bf16)(w0 & 0xffffu); sp[40] = (bf16)(w0 >> 16); sp[80] = (bf16)(w1 & 0xffffu); sp[120] = (bf16)(w1 >> 16); }
                    } else if (ci < 2608) { const int c = ci - 2560; *(f32x4*)(GATE + (size_t)m * 48 + c) = (f32x4){sigmoidf_(v.x), sigmoidf_(v.y), sigmoidf_(v.z), sigmoidf_(v.w)}; }
                }
            }
            if (lane < 20) *(v4u*)(LA + (size_t)m * 256 + 96 + 8 * lane) = (v4u){0u, 0u, 0u, 0u};
            else if (lane >= 32 && lane < 52) *(v4u*)(LA + (size_t)(MTOK + m) * 256 + 96 + 8 * (lane - 32)) = (v4u){0u, 0u, 0u, 0u};
        }
        __syncthreads();
#pragma unroll
        for (int i = 0; i < 4; ++i) { const int idx = F.tid + 512 * i, which = idx >> 10, cc = (idx >> 2) & 255, piece = idx & 3, g = cc >> 6, d = cc & 63;
            const v4u val = *(const LAS v4u*)(stT + (size_t)(which * 256 + cc) * 40 + piece * 8);
            bf16* dst = (which ? VWT : VST) + ((size_t)((b * 4 + g) * 64 + d)) * 2048 + tbase + piece * 8;
            *(v4u*)dst = val; }
        __syncthreads();
    }
}
using pg8::Unit;
struct FStoreF32 { float* O; int ldc;
    __device__ __forceinline__ void operator()(const Unit&, int row, int col, f32x4 v) const { *(f32x4*)(O + (size_t)row * ldc + col) = v; } };
struct FLora { float* WD; float* AA; float* GG; const float* w0; const float* a0;
    __device__ __forceinline__ void operator()(const Unit& u, int row, int col, f32x4 v) const {
        const int s = u.pn >> 2, tok = row - s * MTOK, c = col - s * 1024; const size_t o = (size_t)tok * 1024 + c;
        if (s == 0) { const f32x4 b = *(const f32x4*)(w0 + c); f32x4 r;
#pragma unroll
            for (int i = 0; i < 4; ++i) { const float x = b[i] + v[i]; const float sg = 1.0f / (1.0f + __expf(-x)); r[i] = __expf(-0.6065306597126334f * sg); }
            *(f32x4*)(WD + o) = r; }
        else if (s == 1) { const f32x4 b = *(const f32x4*)(a0 + c); f32x4 r;
#pragma unroll
            for (int i = 0; i < 4; ++i) r[i] = 1.0f / (1.0f + __expf(-(b[i] + v[i])));
            *(f32x4*)(AA + o) = r; }
        else *(f32x4*)(GG + o) = v;
    } };
struct FStoreBf8 { bf16* O; int ldc;
    __device__ __forceinline__ void operator()(const Unit&, int row, int col, f32x4 v0, f32x4 v1) const {
        v4u w; w.x = pk2(v0.x, v0.y); w.y = pk2(v0.z, v0.w); w.z = pk2(v1.x, v1.y); w.w = pk2(v1.z, v1.w); *(v4u*)(O + (size_t)row * ldc + col) = w; } };
__device__ __forceinline__ float gelu_tanh(float x) { const float u = 0.7978845608028654f * (x + 0.044715f * x * x * x); return x / (1.0f + __expf(-2.0f * u)); }
struct FCmp1 { bf16* CH; const float* B1;
    __device__ __forceinline__ void operator()(const Unit& u, int row, int col, f32x4 v0, f32x4 v1) const {
        const int j = u.pm >> 3, ci = col - j * 256; const f32x4 b0 = *(const f32x4*)(B1 + j * 256 + ci), b1 = *(const f32x4*)(B1 + j * 256 + ci + 4);
        v0 = v0 + b0; v1 = v1 + b1; v4u w; w.x = pk2(gelu_tanh(v0.x), gelu_tanh(v0.y)); w.y = pk2(gelu_tanh(v0.z), gelu_tanh(v0.w)); w.z = pk2(gelu_tanh(v1.x), gelu_tanh(v1.y)); w.w = pk2(gelu_tanh(v1.z), gelu_tanh(v1.w));
        *(v4u*)(CH + (size_t)row * 256 + ci) = w; } };
struct FV2 { float* V; const float* VF; const float* v0;
    __device__ __forceinline__ void operator()(const Unit&, int row, int col, f32x4 acc) const {
        const size_t o = (size_t)row * 1024 + col; const f32x4 v = *(const f32x4*)(V + o), vf = *(const f32x4*)(VF + o), b = *(const f32x4*)(v0 + col); f32x4 r;
#pragma unroll
        for (int i = 0; i < 4; ++i) { const float s = 1.0f / (1.0f + __expf(-(b[i] + acc[i]))); r[i] = v[i] + (vf[i] - v[i]) * s; }
        *(f32x4*)(V + o) = r; } };
struct FCmp2 { bf16* KC; bf16* VCT;
    __device__ __forceinline__ void operator()(const Unit& u, int row, int col, f32x4 v) const {
        const int j = u.pm >> 3, ci = col - j * 256; if (ci >= 64) return;
        const int rr = row - j * 2048, bg = rr >> 7, c = rr & 127;
        if (j == 0) { v2u w; w.x = pk2(v.x, v.y); w.y = pk2(v.z, v.w); *(v2u*)(KC + (size_t)(bg * 128 + c) * 64 + ci) = w; }
        else { const unsigned w0 = pk2(v.x, v.y), w1 = pk2(v.z, v.w); bf16* p = VCT + (size_t)(bg * 64 + ci) * 128 + c;
            p[0] = (bf16)(w0 & 0xffffu); p[128] = (bf16)(w0 >> 16); p[256] = (bf16)(w1 & 0xffffu); p[384] = (bf16)(w1 >> 16); }
    } };
struct FResid { float* Z; const float* X; const float* gt;
    __device__ __forceinline__ void operator()(const Unit&, int row, int col, f32x4 acc) const {
        const int b = row >> 11; const size_t o = (size_t)row * DM + col; const f32x4 x = *(const f32x4*)(X + o), g = *(const f32x4*)(gt + (size_t)b * 12288 + col);
        *(f32x4*)(Z + o) = x * DN_ALPHA + (g + 1.0f) * acc; } };
struct FRelu2 { bf16* O;
    __device__ __forceinline__ void operator()(const Unit&, int row, int col, f32x4 v0, f32x4 v1) const {
        f32x4 a, b;
#pragma unroll
        for (int i = 0; i < 4; ++i) { const float x = v0[i] > 0.f ? v0[i] : 0.f, y = v1[i] > 0.f ? v1[i] : 0.f; a[i] = x * x; b[i] = y * y; }
        v4u w; w.x = pk2(a.x, a.y); w.y = pk2(a.z, a.w); w.z = pk2(b.x, b.y); w.w = pk2(b.z, b.w); *(v4u*)(O + (size_t)row * DFF + col) = w; } };

__device__ __forceinline__ void phase_rwkv_elem(Frame& F, const Args& a, int l) {
    const int gw = F.vcu * NWAVES + F.wave, NGW = F.G * NWAVES, lane = F.lane;
    const float* U = (const float*)(F.ws + WS_U); const float* mu = a.in[5] + (size_t)l * RWKV_COLS;
    const float* AA = (const float*)(F.ws + WS_AA); const float* k_k = a.in[11] + l * 1024; const float* k_a = a.in[12] + l * 1024; const float* r_k = a.in[13] + l * 1024;
    float* RR = (float*)(F.ws + WS_RR); float* KK = (float*)(F.ws + WS_KK); float* KM = (float*)(F.ws + WS_KM); float* BV = (float*)(F.ws + WS_BV); float* BON = (float*)(F.ws + WS_BONUS);
    for (int m = gw; m < MTOK; m += NGW) {
        const int t = m & 2047; const float* ur = U + (size_t)m * NINP; const bool hasprev = t > 0;
        f32x4 r4[4], k4[4], a4[4], kr[4]; float ss = 0.f, bon = 0.f;
#pragma unroll
        for (int q = 0; q < 4; ++q) { const int col = 16 * lane + 4 * q;
            f32x4 ru = *(const f32x4*)(ur + col), ku = *(const f32x4*)(ur + 1024 + col), rp = (f32x4){0.f, 0.f, 0.f, 0.f}, kp = rp;
            if (hasprev) { rp = *(const f32x4*)(ur - NINP + col); kp = *(const f32x4*)(ur - NINP + 1024 + col); }
            r4[q] = ru + (rp - ru) * *(const f32x4*)(mu + col); k4[q] = ku + (kp - ku) * *(const f32x4*)(mu + 1024 + col);
            a4[q] = *(const f32x4*)(AA + (size_t)m * 1024 + col);
            kr[q] = k4[q] * *(const f32x4*)(k_k + col);
            ss += (kr[q].x * kr[q].x + kr[q].y * kr[q].y) + (kr[q].z * kr[q].z + kr[q].w * kr[q].w);
            k4[q] = k4[q] * ((a4[q] - 1.0f) * *(const f32x4*)(k_a + col) + 1.0f);
            const f32x4 pr = r4[q] * k4[q] * *(const f32x4*)(r_k + col); bon += (pr.x + pr.y) + (pr.z + pr.w); }
        ss = quad_sum(ss); bon = quad_sum(bon);
        const float nrm = fmaxf(sqrtf(ss), 1e-12f); const float inv = 1.0f / nrm;
#pragma unroll
        for (int q = 0; q < 4; ++q) { const size_t o = (size_t)m * 1024 + 16 * lane + 4 * q; const f32x4 kk = kr[q] * inv;
            *(f32x4*)(RR + o) = r4[q]; *(f32x4*)(KM + o) = k4[q]; *(f32x4*)(KK + o) = kk; *(f32x4*)(BV + o) = kk * a4[q]; }
        if ((lane & 3) == 0) BON[(size_t)m * 16 + (lane >> 2)] = bon;
    }
}
constexpr int SC_TC = 32, SC_BUF_FLOATS = 5 * SC_TC * 64 + SC_TC * 16;
__device__ __forceinline__ void phase_scan(Frame& F, int l) {
    const float* WD = (const float*)(F.ws + WS_WD); const float* KK = (const float*)(F.ws + WS_KK); const float* BV = (const float*)(F.ws + WS_BV);
    const float* KM = (const float*)(F.ws + WS_KM); const float* RR = (const float*)(F.ws + WS_RR); const float* VV = (const float*)(F.ws + (l == 0 ? WS_VF : WS_V));
    float* OS = (float*)(F.ws + WS_OS);
    LAS float* buf = (LAS float*)F.lds;
    const int lane = F.lane, w = F.wave, rl = lane >> 4, kq = lane & 15, tid2 = F.tid - 256;
    for (int it = F.vcu; it < 256; it += F.G) {
        const int bh = it >> 2, q4 = it & 3, b = bh >> 4, h = bh & 15; const size_t m0 = (size_t)b * 2048; const int col0 = h * 64;
        float s0 = 0.f, s1 = 0.f, s2 = 0.f, s3 = 0.f;
        __syncthreads();
#define SC_LOAD(c) do { LAS float* bb = buf + ((c) % 3) * SC_BUF_FLOATS; const size_t mrow = m0 + (size_t)(c) * SC_TC; \
            _Pragma("unroll") for (int i = 0; i < 10; ++i) { const int arr = i >> 1, rem = (i & 1) * 256 + tid2, st = rem >> 4, f4 = rem & 15; \
                const float* src = (arr == 0 ? WD : arr == 1 ? KK : arr == 2 ? BV : arr == 3 ? KM : RR) + (mrow + st) * 1024 + col0 + 4 * f4; \
                *(LAS f32x4*)(bb + (arr * SC_TC + st) * 64 + 4 * f4) = *(const f32x4*)src; } \
            if (tid2 < 128) { const int st = tid2 >> 2, f4 = tid2 & 3; *(LAS f32x4*)(bb + 5 * SC_TC * 64 + st * 16 + 4 * f4) = *(const f32x4*)(VV + (mrow + st) * 1024 + col0 + 16 * q4 + 4 * f4); } } while (0)
        if (w >= 4) { SC_LOAD(0); SC_LOAD(1); }
        for (int c = 0; c < SEQ / SC_TC; ++c) {
            __syncthreads();
            if (w >= 4) { if (c + 2 < SEQ / SC_TC) SC_LOAD(c + 2); }
            else {
                const LAS float* bb = buf + (c % 3) * SC_BUF_FLOATS;
                float* op = OS + (m0 + (size_t)c * SC_TC) * 1024 + col0 + 16 * q4 + 4 * w + rl;
#pragma unroll 4
                for (int st = 0; st < SC_TC; ++st) {
                    const f32x4 w4 = *(const LAS f32x4*)(bb + (0 * SC_TC + st) * 64 + 4 * kq), kk4 = *(const LAS f32x4*)(bb + (1 * SC_TC + st) * 64 + 4 * kq),
                                b4 = *(const LAS f32x4*)(bb + (2 * SC_TC + st) * 64 + 4 * kq), k4 = *(const LAS f32x4*)(bb + (3 * SC_TC + st) * 64 + 4 * kq),
                                r4 = *(const LAS f32x4*)(bb + (4 * SC_TC + st) * 64 + 4 * kq);
                    const float vv = bb[5 * SC_TC * 64 + st * 16 + 4 * w + rl];
                    float d = (s0 * kk4.x + s1 * kk4.y) + (s2 * kk4.z + s3 * kk4.w); d = row16_sum(d);
                    s0 = s0 * w4.x + (vv * k4.x - d * b4.x); s1 = s1 * w4.y + (vv * k4.y - d * b4.y); s2 = s2 * w4.z + (vv * k4.z - d * b4.z); s3 = s3 * w4.w + (vv * k4.w - d * b4.w);
                    float o = (s0 * r4.x + s1 * r4.y) + (s2 * r4.z + s3 * r4.w); o = row16_sum(o);
                    if (kq == 0) op[(size_t)st * 1024] = o;
                }
            }
        }
#undef SC_LOAD
    }
    __syncthreads();
}

constexpr int AT_KSTR = 72;
constexpr int AT_TILE = 64 * AT_KSTR;
struct AttnState { f32x4 O[4][4]; float m[4], l[4]; };
__device__ __forceinline__ float hmax4(f32x4 v) { return fmaxf(fmaxf(v.x, v.y), fmaxf(v.z, v.w)); }
template <int MODE>
__device__ __forceinline__ void attn_half(AttnState& st, const bf16x8 (&qf)[4][2], const LAS bf16* Kt, const LAS bf16* Vt, int a, int keybase, int t, unsigned selmask,
                                          const float (&mfin)[4], const float (&linv)[4], f32x4 (&psum)[2], int lane) {
    asm volatile("" : "+v"(lane));
    const int kr = lane & 15, g4 = lane >> 4;
    bf16x8 kf[2][2];
#pragma unroll
    for (int ds = 0; ds < 2; ++ds)
#pragma unroll
        for (int x = 0; x < 2; ++x) kf[ds][x] = *(const LAS bf16x8*)(Kt + (32 * a + 16 * x + kr) * AT_KSTR + 32 * ds + 8 * g4);
    bool val[2][4];
#pragma unroll
    for (int x = 0; x < 2; ++x)
#pragma unroll
        for (int r = 0; r < 4; ++r) { const int key = keybase + 32 * a + 16 * x + 4 * g4 + r;
            if (MODE <= 1) val[x][r] = (16 * key + 31) <= t;
            else if (MODE == 2) val[x][r] = (key <= t) && ((selmask >> (key >> 6)) & 1u);
            else val[x][r] = (key <= t) && (t - key < 512); }
    bf16x8 pb[4];
#pragma unroll
    for (int hh = 0; hh < 4; ++hh) {
        f32x4 s0 = (f32x4){0.f, 0.f, 0.f, 0.f}, s1 = (f32x4){0.f, 0.f, 0.f, 0.f};
#pragma unroll
        for (int ds = 0; ds < 2; ++ds) { s0 = __builtin_amdgcn_mfma_f32_16x16x32_bf16(kf[ds][0], qf[hh][ds], s0, 0, 0, 0); s1 = __builtin_amdgcn_mfma_f32_16x16x32_bf16(kf[ds][1], qf[hh][ds], s1, 0, 0, 0); }
#pragma unroll
        for (int r = 0; r < 4; ++r) { if (!val[0][r]) s0[r] = NEGBIG; if (!val[1][r]) s1[r] = NEGBIG; }
        f32x4 p0, p1;
        if (MODE == 1) {
#pragma unroll
            for (int r = 0; r < 4; ++r) { p0[r] = val[0][r] ? __expf(s0[r] - mfin[hh]) * linv[hh] : 0.f; p1[r] = val[1][r] ? __expf(s1[r] - mfin[hh]) * linv[hh] : 0.f; }
            psum[0] += p0; psum[1] += p1;
        } else {
            float mloc = fmaxf(hmax4(s0), hmax4(s1));
            mloc = fmaxf(mloc, __shfl_xor(mloc, 16)); mloc = fmaxf(mloc, __shfl_xor(mloc, 32));
            const float mnew = fmaxf(st.m[hh], mloc); const float alpha = __expf(st.m[hh] - mnew);
#pragma unroll
            for (int r = 0; r < 4; ++r) { p0[r] = val[0][r] ? __expf(s0[r] - mnew) : 0.f; p1[r] = val[1][r] ? __expf(s1[r] - mnew) : 0.f; }
            st.l[hh] = st.l[hh] * alpha + ((p0.x + p0.y) + (p0.z + p0.w)) + ((p1.x + p1.y) + (p1.z + p1.w));
            st.m[hh] = mnew;
            if (MODE != 0) {
#pragma unroll
                for (int dt = 0; dt < 4; ++dt) st.O[hh][dt] = st.O[hh][dt] * alpha;
            }
        }
        if (MODE != 0) {
            v4u w; w.x = pk2(p0.x, p0.y); w.y = pk2(p0.z, p0.w); w.z = pk2(p1.x, p1.y); w.w = pk2(p1.z, p1.w);
            pb[hh] = __builtin_bit_cast(bf16x8, w);
        }
        __builtin_amdgcn_sched_barrier(0);
    }
    if (MODE != 0) {
#pragma unroll
        for (int dt = 0; dt < 4; ++dt) {
            const v2u lo = *(const LAS v2u*)(Vt + (16 * dt + kr) * AT_KSTR + 32 * a + 4 * g4);
            const v2u hi = *(const LAS v2u*)(Vt + (16 * dt + kr) * AT_KSTR + 32 * a + 16 + 4 * g4);
            const v4u vv = (v4u){lo.x, lo.y, hi.x, hi.y}; const bf16x8 vf = __builtin_bit_cast(bf16x8, vv);
#pragma unroll
            for (int hh = 0; hh < 4; ++hh) st.O[hh][dt] = __builtin_amdgcn_mfma_f32_16x16x32_bf16(vf, pb[hh], st.O[hh][dt], 0, 0, 0);
        }
    }
}
__device__ __forceinline__ void attn_reset(AttnState& st) {
#pragma unroll
    for (int hh = 0; hh < 4; ++hh) { st.m[hh] = NEGBIG; st.l[hh] = 0.f;
#pragma unroll
        for (int dt = 0; dt < 4; ++dt) st.O[hh][dt] = (f32x4){0.f, 0.f, 0.f, 0.f}; }
}
__device__ __forceinline__ void attn_store(AttnState& st, float* OUT, size_t m, int g, int lane, bool normalise) {
    const int g4 = lane >> 4;
#pragma unroll
    for (int hh = 0; hh < 4; ++hh) {
        float sc = 1.0f;
        if (normalise) { float lt = st.l[hh]; lt += __shfl_xor(lt, 16); lt += __shfl_xor(lt, 32); sc = lt > 0.f ? 1.0f / lt : 0.f; }
#pragma unroll
        for (int dt = 0; dt < 4; ++dt) *(f32x4*)(OUT + m * 1024 + (g * 4 + hh) * 64 + 16 * dt + 4 * g4) = st.O[hh][dt] * sc;
    }
}
__device__ __forceinline__ void phase_nsa(Frame& F) {
    const bf16* QN = (const bf16*)(F.ws + WS_QN); const bf16* KS = (const bf16*)(F.ws + WS_KS); const bf16* KW = (const bf16*)(F.ws + WS_KW);
    const bf16* VST = (const bf16*)(F.ws + WS_VST); const bf16* VWT = (const bf16*)(F.ws + WS_VWT); const bf16* KC = (const bf16*)(F.ws + WS_KC); const bf16* VCT = (const bf16*)(F.ws + WS_VCT);
    float* OCMP = (float*)(F.ws + WS_OCMP); float* OSLC = (float*)(F.ws + WS_OSLC); float* OWIN = (float*)(F.ws + WS_OWIN);
    LAS bf16* Kt = (LAS bf16*)F.lds; LAS bf16* Vt = Kt + 2 * AT_TILE;
    const int lane = F.lane, w = F.wave, qc = lane & 15, g4 = lane >> 4;
    const int srow = F.tid >> 3, spiece = F.tid & 7;
    for (int item = F.vcu; item < 256; item += F.G) {
        const int bg = item >> 4, qb = 15 - (item & 15), b = bg >> 2, g = bg & 3;
        const int q0 = qb * 128, t0 = q0 + 16 * w, t = t0 + qc; const size_t m = (size_t)b * 2048 + t;
        bf16x8 qf[4][2];
#pragma unroll
        for (int hh = 0; hh < 4; ++hh)
#pragma unroll
            for (int ds = 0; ds < 2; ++ds) qf[hh][ds] = *(const bf16x8*)(QN + m * 1024 + (g * 4 + hh) * 64 + 32 * ds + 8 * g4);
        AttnState st; unsigned selmask = 0u;
        float mfin[4] = {0.f, 0.f, 0.f, 0.f}, linv[4] = {0.f, 0.f, 0.f, 0.f}; f32x4 psd[2];
        __syncthreads();
#pragma unroll
        for (int jj = 0; jj < 2; ++jj) {
            *(LAS v4u*)(Kt + jj * AT_TILE + srow * AT_KSTR + spiece * 8) = *(const v4u*)(KC + ((size_t)(bg * 128 + 64 * jj + srow)) * 64 + spiece * 8);
            *(LAS v4u*)(Vt + jj * AT_TILE + srow * AT_KSTR + spiece * 8) = *(const v4u*)(VCT + ((size_t)(bg * 64 + srow)) * 128 + 64 * jj + spiece * 8);
        }
        __syncthreads();
        attn_reset(st);
#pragma unroll
        for (int jj = 0; jj < 2; ++jj)
#pragma unroll
            for (int a = 0; a < 2; ++a) attn_half<0>(st, qf, Kt + jj * AT_TILE, Vt + jj * AT_TILE, a, 64 * jj, t, 0u, mfin, linv, psd, lane);
#pragma unroll
        for (int hh = 0; hh < 4; ++hh) { float lt = st.l[hh]; lt += __shfl_xor(lt, 16); lt += __shfl_xor(lt, 32); mfin[hh] = st.m[hh]; linv[hh] = lt > 0.f ? 1.0f / lt : 0.f; }
        attn_reset(st);
        float imp[8]; float aprev = 0.f; const int cur = t >> 6; const int srcl = (lane + 48) & 63;
#pragma unroll
        for (int jj = 0; jj < 2; ++jj)
#pragma unroll
            for (int a = 0; a < 2; ++a) { f32x4 pp[2]; pp[0] = (f32x4){0.f, 0.f, 0.f, 0.f}; pp[1] = pp[0];
                attn_half<1>(st, qf, Kt + jj * AT_TILE, Vt + jj * AT_TILE, a, 64 * jj, t, 0u, mfin, linv, pp, lane);
#pragma unroll
                for (int x = 0; x < 2; ++x) { const int kt = 4 * jj + 2 * a + x; const float x3 = pp[x].w; const float up = __shfl(x3, srcl); const float prev3 = (g4 != 0) ? up : aprev; aprev = up;
                    const float v = pp[x].x + pp[x].y + pp[x].z + 0.5f * pp[x].w + 0.5f * prev3;
                    const int blk = 4 * kt + g4; const bool forced = (blk == 0) || (blk == cur) || (blk == cur - 1); const bool causal = blk <= cur;
                    imp[kt] = forced ? 1e4f : (causal ? v : -1.0f); } }
        attn_store(st, OCMP, m, g, lane, false);
        {
          unsigned taken = 0u;
#pragma unroll 1
          for (int round = 0; round < 8; ++round) {
              float bv = -3.0e38f; int bi = 1024;
#pragma unroll
              for (int kt = 0; kt < 8; ++kt) { const bool free_ = !((taken >> kt) & 1u); if (free_ && imp[kt] > bv) { bv = imp[kt]; bi = 4 * kt + g4; } }
#pragma unroll
              for (int off = 16; off <= 32; off <<= 1) { const float ov = __shfl_xor(bv, off); const int oi = __shfl_xor(bi, off); if (ov > bv || (ov == bv && oi < bi)) { bv = ov; bi = oi; } }
              selmask |= 1u << (bi & 31);
              if ((bi & 3) == g4) taken |= 1u << (bi >> 2);
          } }
        attn_reset(st);
        { const int jhi = (q0 >> 6) + 1;
          v4u kreg = *(const v4u*)(KS + ((size_t)(bg * 2048 + srow)) * 64 + spiece * 8), vreg = *(const v4u*)(VST + ((size_t)(bg * 64 + srow)) * 2048 + spiece * 8);
          for (int j = 0; j <= jhi; ++j) {
              __syncthreads();
              *(LAS v4u*)(Kt + srow * AT_KSTR + spiece * 8) = kreg; *(LAS v4u*)(Vt + srow * AT_KSTR + spiece * 8) = vreg;
              __syncthreads();
              if (j < jhi) { kreg = *(const v4u*)(KS + ((size_t)(bg * 2048 + 64 * (j + 1) + srow)) * 64 + spiece * 8); vreg = *(const v4u*)(VST + ((size_t)(bg * 64 + srow)) * 2048 + 64 * (j + 1) + spiece * 8); }
              const bool need = (64 * j <= t0 + 15) && (__ballot((selmask >> j) & 1u) != 0ull);
              if (need) {
#pragma unroll
                  for (int a = 0; a < 2; ++a) attn_half<2>(st, qf, Kt, Vt, a, 64 * j, t, selmask, mfin, linv, psd, lane);
              }
          } }
        attn_store(st, OSLC, m, g, lane, true);
        attn_reset(st);
        { const int jlo = q0 >= 512 ? ((q0 - 512) >> 6) : 0, jhi = (q0 >> 6) + 1;
          v4u kreg = *(const v4u*)(KW + ((size_t)(bg * 2048 + 64 * jlo + srow)) * 64 + spiece * 8), vreg = *(const v4u*)(VWT + ((size_t)(bg * 64 + srow)) * 2048 + 64 * jlo + spiece * 8);
          for (int j = jlo; j <= jhi; ++j) {
              __syncthreads();
              *(LAS v4u*)(Kt + srow * AT_KSTR + spiece * 8) = kreg; *(LAS v4u*)(Vt + srow * AT_KSTR + spiece * 8) = vreg;
              __syncthreads();
              if (j < jhi) { kreg = *(const v4u*)(KW + ((size_t)(bg * 2048 + 64 * (j + 1) + srow)) * 64 + spiece * 8); vreg = *(const v4u*)(VWT + ((size_t)(bg * 64 + srow)) * 2048 + 64 * (j + 1) + spiece * 8); }
              const bool need = (64 * j <= t0 + 15) && (64 * j + 63 >= t0 - 511);
              if (need) {
#pragma unroll
                  for (int a = 0; a < 2; ++a) attn_half<3>(st, qf, Kt, Vt, a, 64 * j, t, 0u, mfin, linv, psd, lane);
              }
          } }
        attn_store(st, OWIN, m, g, lane, true);
    }
    __syncthreads();
}
__device__ __forceinline__ void phase_mixprep(Frame& F, const Args& a, int l) {
    const int gw = F.vcu * NWAVES + F.wave, NGW = F.G * NWAVES, lane = F.lane;
    const float* OS = (const float*)(F.ws + WS_OS); const float* GG = (const float*)(F.ws + WS_GG); const float* VV = (const float*)(F.ws + (l == 0 ? WS_VF : WS_V));
    const float* BON = (const float*)(F.ws + WS_BONUS); const float* lg = a.in[14] + l * 1024; const float* lb = a.in[15] + l * 1024;
    const float* OCMP = (const float*)(F.ws + WS_OCMP); const float* OSLC = (const float*)(F.ws + WS_OSLC); const float* OWIN = (const float*)(F.ws + WS_OWIN); const float* GATE = (const float*)(F.ws + WS_GATE);
    bf16* MIX = (bf16*)(F.ws + WS_MIX);
    for (int m = gw; m < MTOK; m += NGW) {
        const int h = lane >> 2; f32x4 o4[4]; float s = 0.f;
#pragma unroll
        for (int q = 0; q < 4; ++q) { o4[q] = *(const f32x4*)(OS + (size_t)m * 1024 + 16 * lane + 4 * q); s += (o4[q].x + o4[q].y) + (o4[q].z + o4[q].w); }
        const float mean = quad_sum(s) * (1.0f / 64.0f); float s2 = 0.f;
#pragma unroll
        for (int q = 0; q < 4; ++q) { o4[q] = o4[q] - mean; s2 += (o4[q].x * o4[q].x + o4[q].y * o4[q].y) + (o4[q].z * o4[q].z + o4[q].w * o4[q].w); }
        const float rstd = 1.0f / sqrtf(quad_sum(s2) * (1.0f / 64.0f) + GN_EPS); const float bon = BON[(size_t)m * 16 + h];
        const float g0 = GATE[(size_t)m * 48 + h * 3 + 0], g1 = GATE[(size_t)m * 48 + h * 3 + 1], g2 = GATE[(size_t)m * 48 + h * 3 + 2];
#pragma unroll
        for (int q = 0; q < 4; ++q) { const int col = 16 * lane + 4 * q; const size_t o = (size_t)m * 1024 + col;
            const f32x4 r = (o4[q] * rstd * *(const f32x4*)(lg + col) + *(const f32x4*)(lb + col) + *(const f32x4*)(VV + o) * bon) * *(const f32x4*)(GG + o);
            v2u w; w.x = pk2(r.x, r.y); w.y = pk2(r.z, r.w); *(v2u*)(MIX + (size_t)m * DM + col) = w;
            const f32x4 n = *(const f32x4*)(OCMP + o) * g0 + *(const f32x4*)(OSLC + o) * g1 + *(const f32x4*)(OWIN + o) * g2;
            v2u w2; w2.x = pk2(n.x, n.y); w2.y = pk2(n.z, n.w); *(v2u*)(MIX + (size_t)m * DM + 1024 + col) = w2; }
    }
}
__device__ __forceinline__ void phase_ln(Frame& F, const float* Z, const float* g, const float* bta, float* X, const float* sc0, const float* sh0, bf16* H) {
    const int gw = F.vcu * NWAVES + F.wave, NGW = F.G * NWAVES, lane = F.lane;
    for (int m = gw; m < MTOK; m += NGW) {
        const int b = m >> 11; const float* zr = Z + (size_t)m * DM; f32x4 v[8]; float s = 0.f;
#pragma unroll
        for (int j = 0; j < 8; ++j) { v[j] = *(const f32x4*)(zr + 4 * (lane + 64 * j)); s += (v[j].x + v[j].y) + (v[j].z + v[j].w); }
        const float mean = wave_sum(s) * (1.0f / DM); float s2 = 0.f;
#pragma unroll
        for (int j = 0; j < 8; ++j) { v[j] = v[j] - mean; s2 += (v[j].x * v[j].x + v[j].y * v[j].y) + (v[j].z * v[j].z + v[j].w * v[j].w); }
        const float rstd = 1.0f / sqrtf(wave_sum(s2) * (1.0f / DM) + LN_EPS);
#pragma unroll
        for (int j = 0; j < 8; ++j) { const int col = 4 * (lane + 64 * j);
            const f32x4 x = v[j] * rstd * *(const f32x4*)(g + col) + *(const f32x4*)(bta + col);
            *(f32x4*)(X + (size_t)m * DM + col) = x;
            if (sc0) { const f32x4 h = x * (*(const f32x4*)(sc0 + (size_t)b * 12288 + col) + 1.0f) + *(const f32x4*)(sh0 + (size_t)b * 12288 + col);
                v2u w; w.x = pk2(h.x, h.y); w.y = pk2(h.z, h.w); *(v2u*)(H + (size_t)m * DM + col) = w; } }
    }
}

#define GEMM_CALL(EPI, SCHED, g, S, E) pg8::gemm_phase<EPI, SCHED, true, true>(F.lds, g, S, E)
__global__ void __launch_bounds__(NWAVES * 64, 2) mk_fwd(Args args) {
    extern __shared__ __attribute__((aligned(16))) unsigned char lds[];
    Frame F;
    F.lds = (LAS unsigned char*)lds;
    F.MISC = (volatile LAS unsigned*)(F.lds + MISC_OFF);
    F.tid = threadIdx.x; F.lane = F.tid & 63; F.wave = __builtin_amdgcn_readfirstlane(F.tid >> 6);
    F.G = gridDim.x; { const int bx = blockIdx.x; F.vcu = (F.G % 8 == 0) ? (bx % 8) * (F.G / 8) + bx / 8 : bx; }
    F.ws = args.ws; F.ctl = (gu32*)(args.ws + WS_CTL);
    for (int u = F.tid; u < (LDS_BYTES - LDSCTL_OFF) / 4; u += NWAVES * 64) ((LAS unsigned*)(F.lds + LDSCTL_OFF))[u] = 0u;
    __syncthreads();
    XcdBarrier bar; bar.bar = (unsigned*)(F.ctl + CW_BAR); bar.x = 0; bar.st = nullptr;
    if (!MK_PER_PHASE) bar = xcd_barrier_post((unsigned*)(F.ctl + CW_BAR), F.MISC + 8);
    const int lo = args.ph_lo, hi = args.ph_hi;
#ifndef MK_SUB
#define MK_SUB 31
#endif
#ifndef MK_PHASE_MASK
#define MK_PHASE_MASK 0x7fff
#endif
#define PH_ON(j) (((MK_PHASE_MASK) >> (j)) & 1)
#define IN(k) (lo <= (k) && (k) < hi)
#define SEAM(k) do { if (IN((k) + 1)) xcd_barrier(bar); } while (0)
#define REFRESH() do { asm volatile("" : "+v"(F.tid)); F.lane = F.tid & 63; F.wave = __builtin_amdgcn_readfirstlane(F.tid >> 6); asm volatile("" : "+s"(F.vcu)); } while (0)
    const int bx = (int)blockIdx.x, G = F.G;

    if (PH_ON(0) && IN(0)) { REFRESH(); phase_pre0(F, args); SEAM(0); }
    if (PH_ON(1) && IN(1)) { REFRESH(); phase_pre1(F, args); SEAM(1); }

    for (int l = 0; l < DEPTH; ++l) {
        const int pb = 2 + 13 * l;
        unsigned char* wl = wlayer(F, l);
        const float* Xin = (l == 0) ? args.in[0] : (const float*)(F.ws + WS_XA);
        if (PH_ON(2) && IN(pb + 0)) { REFRESH();
            pg8::Gemm g{(const bf16*)(F.ws + WS_H), (const bf16*)(wl + WL_IN), DM, DM, DM}; pg8::StaticOrder S; S.init(MTOK, NINP, G, bx);
            pg8::EpiF4<FStoreF32> E{{(float*)(F.ws + WS_U), NINP}};
            GEMM_CALL(pg8::EpiF4<FStoreF32>, pg8::StaticOrder, g, S, E);
            SEAM(pb + 0);
        }
        if (PH_ON(3) && IN(pb + 1)) { REFRESH(); phase_prep(F, args, l); SEAM(pb + 1); }
        if (PH_ON(4) && IN(pb + 2)) { REFRESH();
            if (MK_SUB & 1) { pg8::Gemm g{(const bf16*)(F.ws + WS_KCH), (const bf16*)(wl + WL_C1), 2048, 1024, 2048}; pg8::ListOrder S{16, G, bx, 2};
              pg8::EpiF8<FCmp1> E{{(bf16*)(F.ws + WS_CH), (const float*)(F.ws + WS_B1) + l * 512}};
              GEMM_CALL(pg8::EpiF8<FCmp1>, pg8::ListOrder, g, S, E); }
            if ((MK_SUB & 2) && l > 0) { pg8::Gemm g{(const bf16*)(F.ws + WS_VB), (const bf16*)(wl + WL_V1), 1024, 1024, 1024}; pg8::ListOrder S{32, G, (bx + G - 16) % G, 1};
              pg8::EpiF8<FStoreBf8> E{{(bf16*)(F.ws + WS_V1O), 256}};
              GEMM_CALL(pg8::EpiF8<FStoreBf8>, pg8::ListOrder, g, S, E); }
            if (MK_SUB & 4) { pg8::Gemm g{(const bf16*)(F.ws + WS_LA), (const bf16*)(wl + WL_LORA), 256, 256, 256}; pg8::ListOrder S{384, G, (bx + G - 48) % G, 0};
              pg8::EpiF4<FLora> E{{(float*)(F.ws + WS_WD), (float*)(F.ws + WS_AA), (float*)(F.ws + WS_GG), args.in[6] + l * 1024, args.in[8] + l * 1024}};
              GEMM_CALL(pg8::EpiF4<FLora>, pg8::ListOrder, g, S, E); }
            SEAM(pb + 2);
        }
        if (PH_ON(5) && IN(pb + 3)) { REFRESH();
            if ((MK_SUB & 8) && l > 0) { pg8::Gemm g{(const bf16*)(F.ws + WS_V1O), (const bf16*)(wl + WL_V2), 256, 256, 256}; pg8::ListOrder S{128, G, bx, 3};
              pg8::EpiF4<FV2> E{{(float*)(F.ws + WS_V), (const float*)(F.ws + WS_VF), args.in[16] + (l - 1) * 1024}};
              GEMM_CALL(pg8::EpiF4<FV2>, pg8::ListOrder, g, S, E); }
            if (MK_SUB & 16) { pg8::Gemm g{(const bf16*)(F.ws + WS_CH), (const bf16*)(wl + WL_C2), 256, 256, 256}; pg8::ListOrder S{16, G, (bx + G - 128) % G, 2};
              pg8::EpiF4<FCmp2> E{{(bf16*)(F.ws + WS_KC), (bf16*)(F.ws + WS_VCT)}};
              GEMM_CALL(pg8::EpiF4<FCmp2>, pg8::ListOrder, g, S, E); }
            SEAM(pb + 3);
        }
        if (PH_ON(6) && IN(pb + 4)) { REFRESH(); phase_rwkv_elem(F, args, l); SEAM(pb + 4); }
        if (PH_ON(7) && IN(pb + 5)) { REFRESH(); phase_scan(F, l); if (!IN(pb + 6)) SEAM(pb + 5); }
        if (PH_ON(8) && IN(pb + 6)) { REFRESH(); phase_nsa(F); SEAM(pb + 6); }
        if (PH_ON(9) && IN(pb + 7)) { REFRESH(); phase_mixprep(F, args, l); SEAM(pb + 7); }
        if (PH_ON(10) && IN(pb + 8)) { REFRESH();
            pg8::Gemm g{(const bf16*)(F.ws + WS_MIX), (const bf16*)(wl + WL_OUT), DM, DM, DM}; pg8::StaticOrder S; S.init(MTOK, DM, G, bx);
            pg8::EpiF4<FResid> E{{(float*)(F.ws + WS_Z), Xin, modp(F, l, 0, 2)}};
            GEMM_CALL(pg8::EpiF4<FResid>, pg8::StaticOrder, g, S, E);
            SEAM(pb + 8);
        }
        if (PH_ON(11) && IN(pb + 9)) { REFRESH(); phase_ln(F, (const float*)(F.ws + WS_Z), args.in[23] + l * DM, args.in[24] + l * DM, (float*)(F.ws + WS_XB), modp(F, l, 0, 4), modp(F, l, 0, 3), (bf16*)(F.ws + WS_H)); SEAM(pb + 9); }
        if (PH_ON(12) && IN(pb + 10)) { REFRESH();
            pg8::Gemm g{(const bf16*)(F.ws + WS_H), (const bf16*)(wl + WL_W1), DM, DM, DM}; pg8::StaticOrder S; S.init(MTOK, DFF, G, bx);
            pg8::EpiF8<FRelu2> E{{(bf16*)(F.ws + WS_U)}};
            GEMM_CALL(pg8::EpiF8<FRelu2>, pg8::StaticOrder, g, S, E);
            SEAM(pb + 10);
        }
        if (PH_ON(13) && IN(pb + 11)) { REFRESH();
            pg8::Gemm g{(const bf16*)(F.ws + WS_U), (const bf16*)(wl + WL_W2), DFF, DFF, DFF}; pg8::StaticOrder S; S.init(MTOK, DM, G, bx);
            pg8::EpiF4<FResid> E{{(float*)(F.ws + WS_Z), (const float*)(F.ws + WS_XB), modp(F, l, 0, 5)}};
            GEMM_CALL(pg8::EpiF4<FResid>, pg8::StaticOrder, g, S, E);
            SEAM(pb + 11);
        }
        if (PH_ON(14) && IN(pb + 12)) { REFRESH();
            const bool lastl = (l == DEPTH - 1);
            phase_ln(F, (const float*)(F.ws + WS_Z), args.in[27] + l * DM, args.in[28] + l * DM, lastl ? args.out : (float*)(F.ws + WS_XA),
                     lastl ? nullptr : modp(F, l + 1, 0, 1), lastl ? nullptr : modp(F, l + 1, 0, 0), (bf16*)(F.ws + WS_H));
            if (!lastl) SEAM(pb + 12);
        }
    }
#undef IN
#undef SEAM
}

extern "C" void kernel_launch(void* const* d_in, const int* in_sizes, int n_in, void* d_out, int out_size, void* d_ws, size_t ws_size, hipStream_t stream) {
    static int grid = 0;
    if (grid == 0) {
        if (n_in != 29 || in_sizes[0] != MTOK * DM || out_size != MTOK * DM || ws_size < WS_END) {
            fprintf(stderr, "kernel_launch: unexpected problem: n_in %d in0 %d out %d ws %zu (need %zu); nothing launched\n", n_in, n_in > 0 ? in_sizes[0] : -1, out_size, ws_size, (size_t)WS_END); grid = -1; return; }
        int dev = 0, cus = 0, per_cu = 0;
        if (hipGetDevice(&dev) != hipSuccess || hipDeviceGetAttribute(&cus, hipDeviceAttributeMultiprocessorCount, dev) != hipSuccess) { fprintf(stderr, "kernel_launch: device query failed\n"); grid = -1; return; }
        if (hipFuncSetAttribute((const void*)mk_fwd, hipFuncAttributeMaxDynamicSharedMemorySize, LDS_BYTES) != hipSuccess) { fprintf(stderr, "kernel_launch: hipFuncSetAttribute failed\n"); grid = -1; return; }
        if (hipOccupancyMaxActiveBlocksPerMultiprocessor(&per_cu, (const void*)mk_fwd, NWAVES * 64, LDS_BYTES) != hipSuccess || per_cu < 1)
            fprintf(stderr, "kernel_launch: note: occupancy query reports %d workgroups per CU\n", per_cu);
        (void)hipGetLastError();
        grid = cus;
    }
    if (grid < 0) return;
    if (hipMemsetAsync((char*)d_ws + WS_CTL, 0, CTL_ZERO_BYTES, stream) != hipSuccess) { fprintf(stderr, "kernel_launch: memset failed\n"); return; }
    Args a{};
    for (int i = 0; i < 29; ++i) a.in[i] = (const float*)d_in[i];
    a.out = (float*)d_out; a.ws = (unsigned char*)d_ws;
#if MK_PER_PHASE
    for (int p = 0; p < N_PHASES; ++p) { a.ph_lo = p; a.ph_hi = p + 1; hipLaunchKernelGGL(mk_fwd, dim3(grid), dim3(NWAVES * 64), LDS_BYTES, stream, a); }
#else
    a.ph_lo = 0; a.ph_hi = N_PHASES;
    hipLaunchKernelGGL(mk_fwd, dim3(grid), dim3(NWAVES * 64), LDS_BYTES, stream, a);
#endif
    const hipError_t le = hipPeekAtLastError();
    if (le != hipSuccess) fprintf(stderr, "kernel_launch: launch failed: %s\n", hipGetErrorName(le));
}
```

```cpp
#include <hip/hip_runtime.h>
#include <cstdio>
#include <cstdint>

#ifndef MK_PER_PHASE
#define MK_PER_PHASE 0
#endif

namespace pg8 {
#define PG8_LAS __attribute__((address_space(3)))
typedef unsigned short bf16_t;
typedef short bf16x8 __attribute__((ext_vector_type(8)));
typedef float f32x4 __attribute__((ext_vector_type(4)));
typedef unsigned u32x4 __attribute__((ext_vector_type(4)));
typedef unsigned u32x2 __attribute__((ext_vector_type(2)));
constexpr int BM = 256, BK = 64, HALF = 128, HTB = HALF * BK * 2  , STAGE_BYTES = 8 * HTB, NXCD = 8, WGM = 8;

__host__ __device__ __forceinline__ int lds_byte(int r, int c) { const int st = (r >> 4) * 2 + (c >> 5), rr = r & 15, cc = c & 31, ob = rr * 64 + cc * 2; return st * 1024 + (ob ^ (((ob >> 9) & 1) << 5)); }
__host__ __device__ __forceinline__ void stage_rc(int b, int& R, int& C) { const int st = b / 1024, sb = b % 1024, swz = sb ^ (((sb >> 9) & 1) << 5); R = (st >> 1) * 16 + swz / 64; C = (st & 1) * 32 + (swz % 64) / 2; }
__host__ __device__ __forceinline__ int perm32(int rho) { const int n = rho >> 4, i = rho & 15; return 8 * (i >> 2) + 4 * n + (i & 3); }

struct Unit { int pm, pn; };
struct Gemm { const bf16_t* A; const bf16_t* Bt; int K, lda, ldb; };

struct StaticOrder {
    int nM, nN, nwg, G, c;
    __host__ __device__ void init(int M, int N, int G_, int c_) { nM = M / BM; nN = N / BM; nwg = nM * nN; G = G_; c = c_; }
    __host__ __device__ bool next(int i, Unit& u) const {
        const long L = (long)i * G + c; if (L >= nwg) return false;
        int wgid = (int)L; { const int q = nwg / NXCD, r = nwg % NXCD, xcd = wgid % NXCD, off = wgid / NXCD; wgid = (xcd < r ? xcd * (q + 1) : r * (q + 1) + (xcd - r) * q) + off; }
        const int nig = WGM * nN, gid = wgid / nig, fm = gid * WGM, gsz = (nM - fm) < WGM ? (nM - fm) : WGM;
        u.pm = fm + ((wgid % nig) % gsz); u.pn = (wgid % nig) / gsz; return true;
    }
    __device__ __forceinline__ void a_ready(const Unit&) const {}
    __device__ __forceinline__ void done(const Unit&) const {}
};
struct ListOrder {
    int n, G, c, kind;
    __device__ bool next(int i, Unit& u) const {
        const int L = i * G + c; if (L >= n) return false;
        if (kind == 0) { const int s = L >> 7, r = L & 127; u.pm = s * 32 + (r & 31); u.pn = s * 4 + (r >> 5); }
        else if (kind == 1) { u.pm = L; u.pn = 0; }
        else if (kind == 2) { u.pm = L; u.pn = L >> 3; }
        else { u.pm = L & 31; u.pn = L >> 5; }
        return true;
    }
    __device__ __forceinline__ void a_ready(const Unit&) const {}
    __device__ __forceinline__ void done(const Unit&) const {}
};

__device__ __forceinline__ unsigned cvt_pk_bf16(float lo, float hi) { unsigned r; asm volatile("v_cvt_pk_bf16_f32 %0, %1, %2" : "=v"(r) : "v"(lo), "v"(hi)); return r; }

template <class F> struct EpiF4 {
    static constexpr bool PERM = false, AFTER_DRAIN = false; F f;
    __device__ __forceinline__ void operator()(const f32x4 (&acc)[2][2][4][2], const Unit& u, int wr, int wc, int fr, int fq) const {
#pragma unroll
        for (int ai = 0; ai < 2; ++ai)
#pragma unroll
            for (int m = 0; m < 4; ++m) { const int row = u.pm * BM + ai * HALF + wr * 64 + m * 16 + fr;
#pragma unroll
                for (int bj = 0; bj < 2; ++bj)
#pragma unroll
                    for (int n = 0; n < 2; ++n) { f(u, row, u.pn * BM + bj * HALF + wc * 32 + 16 * n + 4 * fq, acc[ai][bj][m][n]); asm volatile("" ::: "memory"); } }
    }
};
template <class F> struct EpiF8 {
    static constexpr bool PERM = true, AFTER_DRAIN = false; F f;
    __device__ __forceinline__ void operator()(const f32x4 (&acc)[2][2][4][2], const Unit& u, int wr, int wc, int fr, int fq) const {
#pragma unroll
        for (int ai = 0; ai < 2; ++ai)
#pragma unroll
            for (int m = 0; m < 4; ++m) { const int row = u.pm * BM + ai * HALF + wr * 64 + m * 16 + fr;
#pragma unroll
                for (int bj = 0; bj < 2; ++bj) f(u, row, u.pn * BM + bj * HALF + wc * 32 + 8 * fq, acc[ai][bj][m][0], acc[ai][bj][m][1]);
                asm volatile("" ::: "memory"); }
    }
};

template <class Epi, class Sched, bool ALIGN_EPI = false, bool SP2 = false>
__device__ __forceinline__ void gemm_phase(PG8_LAS unsigned char* lds, const Gemm g, const Sched& S, const Epi& E) {
    int tid_ = threadIdx.x; asm volatile("" : "+v"(tid_));
    const int tid = tid_, wid = __builtin_amdgcn_readfirstlane(tid >> 6), lane = tid & 63, wr = wid >> 2, wc = wid & 3, fr = lane & 15, fq = lane >> 4;
    int Kop = g.K; asm volatile("" : "+s"(Kop));
    const int K = Kop, nt = K / BK;
    unsigned voffA[2], voffB[2];
#pragma unroll
    for (int i = 0; i < 2; ++i) { int R, C; stage_rc(tid * 16 + i * 8192, R, C); const int Rb = Epi::PERM ? ((R & ~31) + perm32(R & 31)) : R;
        voffA[i] = (unsigned)(R * g.lda + C) * 2u; voffB[i] = (unsigned)(Rb * g.ldb + C) * 2u; }
    const size_t kstep = (size_t)(BK * 2);
    const size_t hstepA = (size_t)HALF * g.lda * 2, hstepB = (size_t)HALF * g.ldb * 2;
    const size_t tstepA = 2 * hstepA, tstepB = 2 * hstepB;
    const unsigned ldsw = (unsigned)wid * 1024u;
    const int aoff = lds_byte(wr * 64 + fr, fq * 8), boff = lds_byte(wc * 32 + fr, fq * 8);
#define PG8_SA(b, h) (((b) * 2 + (h)) * HTB)
#define PG8_SB(b, h) ((4 + (b) * 2 + (h)) * HTB)
#define PG8_STAGE(bufoff, gbase, voff) do { _Pragma("unroll") for (int _i = 0; _i < 2; ++_i) \
        __builtin_amdgcn_global_load_lds((const unsigned*)((const char*)(gbase) + (voff)[_i]), (PG8_LAS unsigned*)(lds + (bufoff) + ldsw + _i * 8192), 16, 0, 0); } while (0)
#define PG8_LDA(dst, b, h) do { _Pragma("unroll") for (int m = 0; m < 4; ++m) _Pragma("unroll") for (int k = 0; k < 2; ++k) dst[m][k] = *(const PG8_LAS bf16x8*)(lds + PG8_SA(b, h) + aoff + m * 2048 + k * 1024); } while (0)
#define PG8_LDB(dst, b, h) do { _Pragma("unroll") for (int n = 0; n < 2; ++n) _Pragma("unroll") for (int k = 0; k < 2; ++k) dst[n][k] = *(const PG8_LAS bf16x8*)(lds + PG8_SB(b, h) + boff + n * 2048 + k * 1024); } while (0)
#define PG8_MMA(ai, bj, At, Bt) do { __builtin_amdgcn_s_setprio(1); _Pragma("unroll") for (int m = 0; m < 4; ++m) _Pragma("unroll") for (int n = 0; n < 2; ++n) _Pragma("unroll") for (int k = 0; k < 2; ++k) \
        acc[ai][bj][m][n] = __builtin_amdgcn_mfma_f32_16x16x32_bf16(Bt[n][k], At[m][k], acc[ai][bj][m][n], 0, 0, 0); __builtin_amdgcn_s_setprio(0); } while (0)
#define PG8_WAIT_V(n) asm volatile("s_waitcnt vmcnt(" #n ")" ::: "memory")
#define PG8_WAIT_L(n) asm volatile("s_waitcnt lgkmcnt(" #n ")" ::: "memory")
#define PG8_BAR __builtin_amdgcn_s_barrier()
#define PG8_SCHED __builtin_amdgcn_sched_barrier(0)
    Unit cur, nxt; int ui = 0;
    if (!S.next(0, cur)) return;
    f32x4 acc[2][2][4][2];
#pragma unroll
    for (int a = 0; a < 2; ++a)
#pragma unroll
        for (int b = 0; b < 2; ++b)
#pragma unroll
            for (int m = 0; m < 4; ++m)
#pragma unroll
                for (int n = 0; n < 2; ++n) acc[a][b][m][n] = (f32x4){0.f, 0.f, 0.f, 0.f};
    bf16x8 At[4][2], B0[2][2], B1[2][2];
    const char* cA = (const char*)g.A + (size_t)cur.pm * tstepA; const char* cB = (const char*)g.Bt + (size_t)cur.pn * tstepB;
    S.a_ready(cur);
    if constexpr (SP2) {
        PG8_STAGE(PG8_SB(0, 0), cB, voffB); PG8_STAGE(PG8_SB(0, 1), cB + hstepB, voffB); PG8_STAGE(PG8_SA(0, 0), cA, voffA); PG8_STAGE(PG8_SA(0, 1), cA + hstepA, voffA);
        if (wr == 1) PG8_BAR;
        PG8_WAIT_V(2); PG8_BAR;
        PG8_STAGE(PG8_SB(1, 0), cB + kstep, voffB); PG8_STAGE(PG8_SA(1, 0), cA + kstep, voffA); PG8_STAGE(PG8_SB(1, 1), cB + hstepB + kstep, voffB);
        PG8_WAIT_V(6); PG8_BAR;
    } else {
        PG8_STAGE(PG8_SB(0, 0), cB, voffB); PG8_STAGE(PG8_SA(0, 0), cA, voffA); PG8_STAGE(PG8_SB(0, 1), cB + hstepB, voffB); PG8_STAGE(PG8_SA(0, 1), cA + hstepA, voffA);
        if (wr == 1) PG8_BAR;
        PG8_WAIT_V(4); PG8_BAR;
        PG8_STAGE(PG8_SB(1, 0), cB + kstep, voffB); PG8_STAGE(PG8_SA(1, 0), cA + kstep, voffA); PG8_STAGE(PG8_SB(1, 1), cB + hstepB + kstep, voffB);
        PG8_WAIT_V(6); PG8_BAR;
    }
    for (;;) {
        const bool has_next = S.next(ui + 1, nxt);
        const char* nA = has_next ? (const char*)g.A + (size_t)nxt.pm * tstepA : cA; const char* nB = has_next ? (const char*)g.Bt + (size_t)nxt.pn * tstepB : cB;
        for (int t = 0; t < nt; t += 2) {
            const bool last = (t == nt - 2);
            const char* a1 = cA + (size_t)(t + 1) * kstep;
            const char* a2 = last ? nA : cA + (size_t)(t + 2) * kstep; const char* b2 = last ? nB : cB + (size_t)(t + 2) * kstep;
            const char* a3 = a2 + kstep; const char* b3 = b2 + kstep;
            if (last && has_next) S.a_ready(nxt);
            if constexpr (SP2) {
            PG8_LDB(B0, 0, 0); PG8_LDB(B1, 0, 1); PG8_SCHED; PG8_LDA(At, 0, 0); PG8_STAGE(PG8_SA(1, 1), a1 + hstepA, voffA);
            PG8_WAIT_V(8); PG8_WAIT_L(0); PG8_BAR; PG8_MMA(0, 0, At, B0); PG8_MMA(0, 1, At, B1); PG8_BAR; PG8_SCHED;
            PG8_LDA(At, 0, 1); PG8_STAGE(PG8_SB(0, 0), b2, voffB); PG8_STAGE(PG8_SB(0, 1), b2 + hstepB, voffB); PG8_STAGE(PG8_SA(0, 0), a2, voffA);
            PG8_WAIT_V(8); PG8_WAIT_L(0); PG8_BAR; PG8_MMA(1, 0, At, B0); PG8_MMA(1, 1, At, B1); PG8_BAR; PG8_SCHED;
            PG8_LDB(B0, 1, 0); PG8_LDB(B1, 1, 1); PG8_SCHED; PG8_LDA(At, 1, 0); PG8_STAGE(PG8_SA(0, 1), a2 + hstepA, voffA);
            PG8_WAIT_V(8); PG8_WAIT_L(0); PG8_BAR; PG8_MMA(0, 0, At, B0); PG8_MMA(0, 1, At, B1); PG8_BAR; PG8_SCHED;
            PG8_LDA(At, 1, 1); PG8_STAGE(PG8_SB(1, 0), b3, voffB); PG8_STAGE(PG8_SB(1, 1), b3 + hstepB, voffB); PG8_STAGE(PG8_SA(1, 0), a3, voffA);
            PG8_WAIT_V(8); PG8_WAIT_L(0); PG8_BAR; PG8_MMA(1, 0, At, B0); PG8_MMA(1, 1, At, B1); PG8_BAR; PG8_SCHED;
            } else {
            PG8_LDB(B0, 0, 0); PG8_SCHED; PG8_LDA(At, 0, 0); PG8_STAGE(PG8_SA(1, 1), a1 + hstepA, voffA);
            PG8_WAIT_L(8); PG8_BAR; PG8_WAIT_L(0); PG8_MMA(0, 0, At, B0); PG8_BAR; PG8_SCHED;
            PG8_LDB(B1, 0, 1); PG8_STAGE(PG8_SB(0, 0), b2, voffB);
            PG8_BAR; PG8_WAIT_L(0); PG8_MMA(0, 1, At, B1); PG8_BAR;
            PG8_LDA(At, 0, 1); PG8_STAGE(PG8_SA(0, 0), a2, voffA);
            PG8_BAR; PG8_WAIT_L(0); PG8_MMA(1, 0, At, B0); PG8_BAR; PG8_SCHED;
            PG8_STAGE(PG8_SB(0, 1), b2 + hstepB, voffB);
            PG8_WAIT_V(6); PG8_BAR; PG8_MMA(1, 1, At, B1); PG8_BAR;
            PG8_LDB(B0, 1, 0); PG8_SCHED; PG8_LDA(At, 1, 0); PG8_STAGE(PG8_SA(0, 1), a2 + hstepA, voffA);
            PG8_WAIT_L(8); PG8_BAR; PG8_WAIT_L(0); PG8_MMA(0, 0, At, B0); PG8_BAR; PG8_SCHED;
            PG8_LDB(B1, 1, 1); PG8_STAGE(PG8_SB(1, 0), b3, voffB);
            PG8_BAR; PG8_WAIT_L(0); PG8_MMA(0, 1, At, B1); PG8_BAR;
            PG8_LDA(At, 1, 1); PG8_STAGE(PG8_SA(1, 0), a3, voffA);
            PG8_BAR; PG8_WAIT_L(0); PG8_MMA(1, 0, At, B0); PG8_BAR; PG8_SCHED;
            PG8_STAGE(PG8_SB(1, 1), b3 + hstepB, voffB);
            PG8_WAIT_V(6); PG8_BAR; PG8_MMA(1, 1, At, B1); PG8_BAR;
            }
        }
        if constexpr (ALIGN_EPI) { if (wr == 0) PG8_BAR; }
        if constexpr (!Epi::AFTER_DRAIN) { E(acc, cur, wr, wc, fr, fq); S.done(cur); }
        if (!has_next) break;
#pragma unroll
        for (int a = 0; a < 2; ++a)
#pragma unroll
            for (int b = 0; b < 2; ++b)
#pragma unroll
                for (int m = 0; m < 4; ++m)
#pragma unroll
                    for (int n = 0; n < 2; ++n) acc[a][b][m][n] = (f32x4){0.f, 0.f, 0.f, 0.f};
        cur = nxt; cA = nA; cB = nB; ++ui;
        if constexpr (ALIGN_EPI) { if (wr == 1) PG8_BAR; }
    }
    PG8_WAIT_V(0);
    if constexpr (!ALIGN_EPI) { if (wr == 0) PG8_BAR; }
    PG8_BAR;
    if constexpr (Epi::AFTER_DRAIN) { E.fused(acc, cur, wr, wc, fr, fq, lds, wid, lane); S.done(cur); }
#undef PG8_SA
#undef PG8_SB
#undef PG8_STAGE
#undef PG8_LDA
#undef PG8_LDB
#undef PG8_MMA
#undef PG8_WAIT_V
#undef PG8_WAIT_L
#undef PG8_BAR
#undef PG8_SCHED
}
}

constexpr int NWAVES = 8;
constexpr int BATCH = 4, SEQ = 2048, DM = 2048, DEPTH = 4, MTOK = BATCH * SEQ;
constexpr int DR = 1024, DN = 1024, NKV = 256, DFF = 8192;
constexpr int RWKV_COLS = 3520, NSA_COLS = 2608, IN_COLS = 6128, NINP = 6144;
constexpr float LN_EPS = 1e-5f, GN_EPS = 64e-5f;
constexpr float DN_ALPHA = 1.681792830507429f;
constexpr float NEGBIG = -1e30f;
constexpr int N_PHASES = 2 + 13 * DEPTH;

constexpr size_t KiB = 1024, MiB = 1u << 20;
constexpr size_t WS_CTL = 0, CTL_ZERO_BYTES = 1 * MiB;
constexpr int CW_BAR = 4096;
constexpr size_t WS_MOD = 1 * MiB;
constexpr size_t WS_ROPE = WS_MOD + 786432;
constexpr size_t WS_B1 = WS_ROPE + 524288;
constexpr size_t WS_WT = 3 * MiB;
constexpr size_t WL_IN = 0, WL_OUT = WL_IN + (size_t)NINP * DM * 2, WL_W1 = WL_OUT + (size_t)DM * DM * 2, WL_W2 = WL_W1 + (size_t)DFF * DM * 2,
                 WL_LORA = WL_W2 + (size_t)DM * DFF * 2, WL_V1 = WL_LORA + (size_t)3072 * 256 * 2, WL_V2 = WL_V1 + (size_t)256 * 1024 * 2,
                 WL_C1 = WL_V2 + (size_t)1024 * 256 * 2, WL_C2 = WL_C1 + (size_t)512 * 2048 * 2, WL_STRIDE = WL_C2 + (size_t)512 * 256 * 2;
constexpr size_t ACT_F32 = (size_t)MTOK * DM * 4;
constexpr size_t R1024_F32 = (size_t)MTOK * 1024 * 4;
constexpr size_t WS_XA = WS_WT + 4 * WL_STRIDE + 1 * MiB;
constexpr size_t WS_XB = WS_XA + ACT_F32, WS_Z = WS_XB + ACT_F32, WS_H = WS_Z + ACT_F32;
constexpr size_t WS_U = WS_H + (size_t)MTOK * DM * 2;
constexpr size_t WS_LA = WS_U + (size_t)MTOK * NINP * 4;
constexpr size_t WS_VB = WS_LA + (size_t)3 * MTOK * 256 * 2;
constexpr size_t WS_V1O = WS_VB + (size_t)MTOK * 1024 * 2;
constexpr size_t WS_VF = WS_V1O + (size_t)MTOK * 256 * 2;
constexpr size_t WS_V = WS_VF + R1024_F32, WS_WD = WS_V + R1024_F32, WS_AA = WS_WD + R1024_F32, WS_GG = WS_AA + R1024_F32, WS_RR = WS_GG + R1024_F32,
                 WS_KK = WS_RR + R1024_F32, WS_KM = WS_KK + R1024_F32, WS_BV = WS_KM + R1024_F32, WS_OS = WS_BV + R1024_F32,
                 WS_OCMP = WS_OS + R1024_F32, WS_OSLC = WS_OCMP + R1024_F32, WS_OWIN = WS_OSLC + R1024_F32, WS_BONUS = WS_OWIN + R1024_F32;
constexpr size_t WS_QN = WS_BONUS + (size_t)MTOK * 16 * 4;
constexpr size_t WS_KCH = WS_QN + (size_t)MTOK * 1024 * 2;
constexpr size_t WS_VCH = WS_KCH + (size_t)16 * 2048 * 64 * 2;
constexpr size_t WS_KS = WS_VCH + (size_t)16 * 2048 * 64 * 2 + 4096;
constexpr size_t WS_KW = WS_KS + (size_t)16 * 2048 * 64 * 2, WS_VST = WS_KW + (size_t)16 * 2048 * 64 * 2, WS_VWT = WS_VST + (size_t)16 * 2048 * 64 * 2;
constexpr size_t WS_GATE = WS_VWT + (size_t)16 * 2048 * 64 * 2;
constexpr size_t WS_CH = WS_GATE + (size_t)MTOK * 48 * 4;
constexpr size_t WS_KC = WS_CH + (size_t)4096 * 256 * 2;
constexpr size_t WS_VCT = WS_KC + (size_t)16 * 128 * 64 * 2;
constexpr size_t WS_MIX = WS_VCT + (size_t)16 * 64 * 128 * 2;
constexpr size_t WS_END = WS_MIX + (size_t)MTOK * DM * 2;
static_assert((size_t)MTOK * DFF * 2 <= (size_t)MTOK * NINP * 4, "HID overlays U");
static_assert(WS_END < (size_t)1560 * MiB, "workspace map too large");

constexpr int RING_BYTES = 131072;
constexpr int LDSCTL_OFF = RING_BYTES, MISC_OFF = LDSCTL_OFF + 320;
constexpr int LDS_BYTES = 147456;

#define GAS __attribute__((address_space(1)))
#define LAS __attribute__((address_space(3)))
typedef unsigned short bf16;
typedef unsigned v4u __attribute__((ext_vector_type(4)));
typedef unsigned v2u __attribute__((ext_vector_type(2)));
typedef float f32x4 __attribute__((ext_vector_type(4)));
typedef float f32x2 __attribute__((ext_vector_type(2)));
typedef short bf16x8 __attribute__((ext_vector_type(8)));
typedef short bf16x4 __attribute__((ext_vector_type(4)));
typedef GAS unsigned gu32;
#define RLX_AGENT __ATOMIC_RELAXED, __HIP_MEMORY_SCOPE_AGENT
#define LDS_WAIT() asm volatile("s_waitcnt lgkmcnt(0)" ::: "memory")
#define VM_WAIT() asm volatile("s_waitcnt vmcnt(0)" ::: "memory")
__device__ __forceinline__ unsigned pk2(float lo, float hi) { return pg8::cvt_pk_bf16(lo, hi); }
__device__ __forceinline__ float bf2f(unsigned short b) { return __uint_as_float((unsigned)b << 16); }
__device__ __forceinline__ float sigmoidf_(float x) { return 1.0f / (1.0f + __expf(-x)); }
__device__ __forceinline__ float wave_sum(float v) {
#pragma unroll
    for (int o = 1; o < 64; o <<= 1) v += __shfl_xor(v, o);
    return v;
}
template <int CTRL> __device__ __forceinline__ float dppf(float x) { return __int_as_float(__builtin_amdgcn_mov_dpp(__float_as_int(x), CTRL, 0xF, 0xF, true)); }
__device__ __forceinline__ float row16_sum(float x) { x += dppf<0xB1>(x); x += dppf<0x4E>(x); x += dppf<0x141>(x); x += dppf<0x140>(x); return x; }
__device__ __forceinline__ float quad_sum(float x) { x += dppf<0xB1>(x); x += dppf<0x4E>(x); return x; }

#define XB_TMO      128
#define XB_XCNT(j)  (256  + 64 * (j))
#define XB_XSUB(j)  (1280 + 64 * (j))
#define XB_XGEN(j)  (2304 + 64 * (j))
#define XB_TOP      3328
#define XB_TOPGEN   3392
#define XCD_BAR_WORDS 3456
#define XB_SPIN_CAP (1u << 18)

__device__ __forceinline__ unsigned xb_ld(unsigned* p)              { return __hip_atomic_load(p, __ATOMIC_RELAXED, __HIP_MEMORY_SCOPE_AGENT); }
__device__ __forceinline__ unsigned xb_add(unsigned* p, unsigned v) { return __hip_atomic_fetch_add(p, v, __ATOMIC_RELAXED, __HIP_MEMORY_SCOPE_AGENT); }
__device__ __forceinline__ unsigned xb_xcc_id() { return (unsigned)__builtin_amdgcn_s_getreg((3 << 11) | 20) & 0xFu; }
#define XB_SPIN(cond, bar) do { unsigned _sp = 0; while (cond) { __builtin_amdgcn_s_sleep(1); \
    if ((++_sp & 255u) == 0u) { if (xb_ld(&(bar)[XB_TMO])) break; if (_sp > XB_SPIN_CAP) { atomicAdd(&(bar)[XB_TMO], 1u); break; } } } } while (0)

struct XcdBarrier {
    unsigned* bar; unsigned x;
    volatile LAS unsigned* st;
};

__device__ __forceinline__ XcdBarrier xcd_barrier_post(unsigned* bar, volatile LAS unsigned* st) {
    XcdBarrier b; b.bar = bar; b.x = xb_xcc_id(); b.st = st;
    if (threadIdx.x == 0) (void)xb_add(&bar[XB_XCNT(b.x)], 1u);
    return b;
}
__device__ __forceinline__ void xcd_barrier_complete(unsigned* bar, unsigned x, unsigned& nloc, unsigned& nx) {
    const unsigned G = gridDim.x * gridDim.y * gridDim.z;
    unsigned sum, cnt, mine, sp = 0u;
    for (;;) {
        sum = 0u; cnt = 0u; mine = 0u;
#pragma unroll
        for (unsigned j = 0; j < 16; ++j) { const unsigned c = xb_ld(&bar[XB_XCNT(j)]); sum += c; cnt += (c > 0u) ? 1u : 0u; mine = (j == x) ? c : mine; }
        if (sum == G) break;
        __builtin_amdgcn_s_sleep(1);
        if ((++sp & 255u) == 0u) { if (xb_ld(&bar[XB_TMO])) break; if (sp > XB_SPIN_CAP) { atomicAdd(&bar[XB_TMO], 1u); break; } }
    }
    nloc = mine > 0u ? mine : 1u; nx = cnt > 0u ? cnt : 1u;
}

__device__ __forceinline__ void xcd_barrier(const XcdBarrier& b) {
    asm volatile("s_waitcnt vmcnt(0)" ::: "memory");
    __syncthreads();
    if (threadIdx.x == 0) {
        unsigned* bar = b.bar;
        __builtin_amdgcn_s_waitcnt(0);
        unsigned nloc = b.st[0], nx = b.st[1];
        if (nloc == 0u) { xcd_barrier_complete(bar, b.x, nloc, nx); b.st[0] = nloc; b.st[1] = nx; }
        const unsigned old = xb_add(&bar[XB_XSUB(b.x)], 1u);
        const unsigned gen = old / nloc;
        if (old + 1u == (gen + 1u) * nloc) {
            __builtin_amdgcn_fence(__ATOMIC_RELEASE, "agent");
            asm volatile("s_waitcnt vmcnt(0)" ::: "memory");
            const unsigned og = xb_add(&bar[XB_TOP], 1u);
            const unsigned tg = og / nx;
            if (og + 1u == (tg + 1u) * nx) xb_add(&bar[XB_TOPGEN], 1u);
            else XB_SPIN(xb_ld(&bar[XB_TOPGEN]) == tg, bar);
            __builtin_amdgcn_fence(__ATOMIC_ACQUIRE, "agent");
            xb_add(&bar[XB_XGEN(b.x)], 1u);
            asm volatile("s_waitcnt vmcnt(0)" ::: "memory");
        } else {
            XB_SPIN(xb_ld(&bar[XB_XGEN(b.x)]) == gen, bar);
            __builtin_amdgcn_fence(__ATOMIC_ACQUIRE, "agent");
            asm volatile("s_waitcnt vmcnt(0)" ::: "memory");
        }
    }
    __syncthreads();
}

struct Args { const float* in[29]; float* out; unsigned char* ws; int ph_lo, ph_hi; };
struct Frame {
    LAS unsigned char* lds;
    volatile LAS unsigned* MISC;
    gu32* ctl;
    int tid, lane, wave, vcu, G;
    GAS unsigned char* ws;
};
__device__ __forceinline__ const float* modp(const Frame& F, int l, int b, int which) { return (const float*)(F.ws + WS_MOD) + ((size_t)(l * 4 + b) * 12288 + which * 2048); }
__device__ __forceinline__ GAS unsigned char* wlayer(const Frame& F, int l) { return F.ws + WS_WT + (size_t)l * WL_STRIDE; }

struct CDesc { const float* src; bf16* dst; int ldw, Kv, Nv, Kp, Np; };
__device__ __forceinline__ bool conv_desc(const Args& a, const Frame& F, int l, int kind, CDesc& d) {
    GAS unsigned char* wl = wlayer(F, l);
    switch (kind) {
    case 0: d.src = a.in[4] + (size_t)l * 2048 * 6128; d.dst = (bf16*)(wl + WL_IN); d.ldw = 6128; d.Kv = 2048; d.Nv = 6128; d.Kp = 2048; d.Np = 6144; return true;
    case 1: d.src = a.in[22] + (size_t)l * 2048 * 2048; d.dst = (bf16*)(wl + WL_OUT); d.ldw = 2048; d.Kv = 2048; d.Nv = 2048; d.Kp = 2048; d.Np = 2048; return true;
    case 2: d.src = a.in[25] + (size_t)l * 2048 * 8192; d.dst = (bf16*)(wl + WL_W1); d.ldw = 8192; d.Kv = 2048; d.Nv = 8192; d.Kp = 2048; d.Np = 8192; return true;
    case 3: d.src = a.in[26] + (size_t)l * 8192 * 2048; d.dst = (bf16*)(wl + WL_W2); d.ldw = 2048; d.Kv = 8192; d.Nv = 2048; d.Kp = 8192; d.Np = 2048; return true;
    case 4: d.src = a.in[7] + (size_t)l * 96 * 1024; d.dst = (bf16*)(wl + WL_LORA); d.ldw = 1024; d.Kv = 96; d.Nv = 1024; d.Kp = 256; d.Np = 1024; return true;
    case 5: d.src = a.in[9] + (size_t)l * 96 * 1024; d.dst = (bf16*)(wl + WL_LORA) + (size_t)1024 * 256; d.ldw = 1024; d.Kv = 96; d.Nv = 1024; d.Kp = 256; d.Np = 1024; return true;
    case 6: d.src = a.in[10] + (size_t)l * 256 * 1024; d.dst = (bf16*)(wl + WL_LORA) + (size_t)2048 * 256; d.ldw = 1024; d.Kv = 256; d.Nv = 1024; d.Kp = 256; d.Np = 1024; return true;
    case 7: if (l == 0) return false; d.src = a.in[17] + (size_t)(l - 1) * 1024 * 64; d.dst = (bf16*)(wl + WL_V1); d.ldw = 64; d.Kv = 1024; d.Nv = 64; d.Kp = 1024; d.Np = 256; return true;
    case 8: if (l == 0) return false; d.src = a.in[18] + (size_t)(l - 1) * 64 * 1024; d.dst = (bf16*)(wl + WL_V2); d.ldw = 1024; d.Kv = 64; d.Nv = 1024; d.Kp = 256; d.Np = 1024; return true;
    case 9: d.src = a.in[20] + (size_t)(l * 2) * 2048 * 256; d.dst = (bf16*)(wl + WL_C1); d.ldw = 256; d.Kv = 2048; d.Nv = 256; d.Kp = 2048; d.Np = 256; return true;
    case 10: d.src = a.in[20] + (size_t)(l * 2 + 1) * 2048 * 256; d.dst = (bf16*)(wl + WL_C1) + (size_t)256 * 2048; d.ldw = 256; d.Kv = 2048; d.Nv = 256; d.Kp = 2048; d.Np = 256; return true;
    case 11: d.src = a.in[21] + (size_t)(l * 2) * 256 * 64; d.dst = (bf16*)(wl + WL_C2); d.ldw = 64; d.Kv = 256; d.Nv = 64; d.Kp = 256; d.Np = 256; return true;
    default: d.src = a.in[21] + (size_t)(l * 2 + 1) * 256 * 64; d.dst = (bf16*)(wl + WL_C2) + (size_t)256 * 256; d.ldw = 64; d.Kv = 256; d.Nv = 64; d.Kp = 256; d.Np = 256; return true;
    }
}
__device__ __forceinline__ void transpose_item(const CDesc& d, LAS float* scr, int item, int lane) {
    const int nblk = d.Np / 32, kb = item / nblk, nb = item % nblk, k0 = 64 * kb, n0 = 32 * nb;
    const int n4 = lane & 7, n = n0 + 4 * n4; const bool nok = n < d.Nv;
    f32x4 v[8];
#pragma unroll
    for (int i = 0; i < 8; ++i) { const int k = k0 + 8 * i + (lane >> 3); v[i] = (f32x4){0.f, 0.f, 0.f, 0.f}; if (nok && k < d.Kv) v[i] = *(const f32x4*)(d.src + (size_t)k * d.ldw + n); }
#pragma unroll
    for (int i = 0; i < 8; ++i) { LAS float* p = scr + (8 * i + (lane >> 3)) * 33 + 4 * n4; p[0] = v[i].x; p[1] = v[i].y; p[2] = v[i].z; p[3] = v[i].w; }
    LDS_WAIT(); asm volatile("" ::: "memory");
    const int c = lane & 7;
#pragma unroll
    for (int j = 0; j < 4; ++j) { const int nn = (lane >> 3) + 8 * j; const LAS float* s = scr + (8 * c) * 33 + nn;
        v4u o; o.x = pk2(s[0 * 33], s[1 * 33]); o.y = pk2(s[2 * 33], s[3 * 33]); o.z = pk2(s[4 * 33], s[5 * 33]); o.w = pk2(s[6 * 33], s[7 * 33]);
        *(GAS v4u*)(d.dst + (size_t)(n0 + nn) * d.Kp + k0 + 8 * c) = o; }
    LDS_WAIT(); asm volatile("" ::: "memory");
}
__device__ __forceinline__ void rope_entry(int idx, f32x2* tab) {
    const int t = idx >> 5, i = idx & 31;
    double p = 1.0; for (int n = 0; n < i; ++n) p *= 0.7498942093324559;
    const float invf = (float)p; const float angf = (float)t * invf;
    const double x = (double)angf; const double kd = __builtin_rint(x * 0.6366197723675814); const int q = (int)kd;
    double r = __builtin_fma(-kd, 1.5707963267948966, x); r = __builtin_fma(-kd, 6.123233995736766e-17, r);
    const double r2 = r * r;
    const double s = r * (1.0 + r2 * (-1.0 / 6.0 + r2 * (1.0 / 120.0 + r2 * (-1.0 / 5040.0 + r2 * (1.0 / 362880.0 + r2 * (-1.0 / 39916800.0 + r2 * (1.0 / 6227020800.0 + r2 * (-1.0 / 1307674368000.0))))))));
    const double c = 1.0 + r2 * (-0.5 + r2 * (1.0 / 24.0 + r2 * (-1.0 / 720.0 + r2 * (1.0 / 40320.0 + r2 * (-1.0 / 3628800.0 + r2 * (1.0 / 479001600.0 + r2 * (-1.0 / 87178291200.0 + r2 * (1.0 / 20922789888000.0))))))));
    double cs, sn; const int qq = q & 3;
    if (qq == 0) { cs = c; sn = s; } else if (qq == 1) { cs = -s; sn = c; } else if (qq == 2) { cs = -c; sn = -s; } else { cs = s; sn = -c; }
    tab[idx] = (f32x2){(float)cs, (float)sn};
}
__device__ __forceinline__ void phase_pre0(Frame& F, const Args& a) {
    LAS float* condT = (LAS float*)(F.lds);
    LAS float* part = (LAS float*)(F.lds + 32768);
    LAS float* pv = (LAS float*)(F.lds + 40960);
    { const float* c = a.in[1];
      for (int i = F.tid; i < 8192; i += 512) { const int k = i >> 2, b = i & 3; const float x = c[b * 2048 + k]; condT[i] = x / (1.f + __expf(-x)); }
      __syncthreads();
      float* mod = (float*)(F.ws + WS_MOD);
      for (int it = blockIdx.x; it < 768; it += F.G) {
          const int l = it / 192, n0 = (it % 192) * 64;
          const float* W = a.in[2] + (size_t)l * 2048 * 12288 + n0 + F.lane;
          float a0 = 0.f, a1 = 0.f, a2 = 0.f, a3 = 0.f; const int k0 = F.wave * 256;
#pragma unroll 16
          for (int kk = 0; kk < 256; ++kk) { const int k = k0 + kk; const float wv = W[(size_t)k * 12288]; const f32x4 cv = *(const LAS f32x4*)(condT + 4 * k);
              a0 += cv.x * wv; a1 += cv.y * wv; a2 += cv.z * wv; a3 += cv.w * wv; }
          part[(F.wave * 4 + 0) * 64 + F.lane] = a0; part[(F.wave * 4 + 1) * 64 + F.lane] = a1; part[(F.wave * 4 + 2) * 64 + F.lane] = a2; part[(F.wave * 4 + 3) * 64 + F.lane] = a3;
          __syncthreads();
          if (F.tid < 256) { const int b = F.tid >> 6, n = F.tid & 63; float s = 0.f;
#pragma unroll
              for (int w = 0; w < 8; ++w) s += part[(w * 4 + b) * 64 + n];
              mod[(size_t)(l * 4 + b) * 12288 + n0 + n] = s + a.in[3][l * 12288 + n0 + n]; }
          __syncthreads();
      } }
    { float* B1 = (float*)(F.ws + WS_B1);
      for (int it = (int)blockIdx.x - 64; it < 32; it += F.G) {
          if (it < 0) continue;
          const int l = it >> 3, j = (it >> 2) & 1, cg = it & 3;
          const float* pos = a.in[19] + (size_t)(l * 2 + j) * 2048;
          for (int i = F.tid; i < 2048; i += 512) pv[i] = pos[i];
          __syncthreads();
          const float* W = a.in[20] + (size_t)(l * 2 + j) * 2048 * 256 + cg * 64 + F.lane;
          float acc = 0.f; const int k0 = F.wave * 256;
#pragma unroll 8
          for (int kk = 0; kk < 256; ++kk) acc += pv[k0 + kk] * W[(size_t)(k0 + kk) * 256];
          part[F.wave * 64 + F.lane] = acc;
          __syncthreads();
          if (F.tid < 64) { float s = 0.f;
#pragma unroll
              for (int w = 0; w < 8; ++w) s += part[w * 64 + F.tid];
              B1[(l * 2 + j) * 256 + cg * 64 + F.tid] = s; }
          __syncthreads();
      } }
    { f32x2* tab = (f32x2*)(F.ws + WS_ROPE);
      for (int idx = blockIdx.x * 512 + F.tid; idx < 2048 * 32; idx += F.G * 512) rope_entry(idx, tab); }
    { __syncthreads();
      LAS float* scr = (LAS float*)(F.lds + F.wave * 16384);
      const int gw = F.vcu * NWAVES + F.wave, NGW = F.G * NWAVES; int off = 0;
      for (int l = 0; l < DEPTH; ++l)
          for (int kind = 0; kind < 13; ++kind) {
              CDesc d; if (!conv_desc(a, F, l, kind, d)) continue;
              const int nitems = (d.Kp / 64) * (d.Np / 32);
              int start = gw - (off % NGW); if (start < 0) start += NGW;
              for (int it = start; it < nitems; it += NGW) transpose_item(d, scr, it, F.lane);
              off += nitems;
          }
      __syncthreads(); }
}
__device__ __forceinline__ void phase_pre1(Frame& F, const Args& a) {
    const int gw = F.vcu * NWAVES + F.wave, NGW = F.G * NWAVES;
    bf16* H = (bf16*)(F.ws + WS_H);
    for (int m = gw; m < MTOK; m += NGW) {
        const int b = m >> 11; const float* xr = a.in[0] + (size_t)m * DM; const float* sh = modp(F, 0, b, 0); const float* sc = modp(F, 0, b, 1);
#pragma unroll
        for (int j = 0; j < 8; ++j) { const int col = 4 * (F.lane + 64 * j);
            const f32x4 xv = *(const f32x4*)(xr + col), s4 = *(const f32x4*)(sc + col), h4 = *(const f32x4*)(sh + col);
            const f32x4 h = xv * (s4 + 1.0f) + h4; v2u o; o.x = pk2(h.x, h.y); o.y = pk2(h.z, h.w);
            *(v2u*)(H + (size_t)m * DM + col) = o; }
    }
}
__device__ __forceinline__ void phase_prep(Frame& F, const Args& a, int l) {
    LAS bf16* stT = (LAS bf16*)(F.lds);
    const float* U = (const float*)(F.ws + WS_U); const float* mu = a.in[5] + (size_t)l * RWKV_COLS;
    const f32x2* rope = (const f32x2*)(F.ws + WS_ROPE);
    bf16* LA = (bf16*)(F.ws + WS_LA); float* V0 = (float*)(F.ws + (l == 0 ? WS_VF : WS_V)); bf16* VB = (bf16*)(F.ws + WS_VB);
    bf16* QN = (bf16*)(F.ws + WS_QN); bf16* KCH = (bf16*)(F.ws + WS_KCH); bf16* VCH = (bf16*)(F.ws + WS_VCH); bf16* KS = (bf16*)(F.ws + WS_KS); bf16* KW = (bf16*)(F.ws + WS_KW);
    bf16* VST = (bf16*)(F.ws + WS_VST); bf16* VWT = (bf16*)(F.ws + WS_VWT); float* GATE = (float*)(F.ws + WS_GATE);
    if (blockIdx.x == 0 && F.tid < 256) *(v4u*)(F.ws + WS_VCH + (size_t)16 * 2048 * 64 * 2 + F.tid * 16) = (v4u){0u, 0u, 0u, 0u};
    const int lane = F.lane;
    for (int item = blockIdx.x; item < MTOK / 32; item += F.G) {
        const int m0 = item * 32, b = m0 >> 11, tbase = m0 & 2047;
        for (int tl4 = 0; tl4 < 4; ++tl4) {
            const int tl = F.wave * 4 + tl4, m = m0 + tl, t = tbase + tl;
            const float* ur = U + (size_t)m * NINP; const bool hasprev = t > 0;
            for (int s = 8; s < 24; ++s) {
                const int col = s * 256 + 4 * lane;
                f32x4 v = *(const f32x4*)(ur + col);
                if (col < RWKV_COLS) { f32x4 pvv = (f32x4){0.f, 0.f, 0.f, 0.f}; if (hasprev) pvv = *(const f32x4*)(ur - NINP + col);
                    const f32x4 m4 = *(const f32x4*)(mu + col); v = v + (pvv - v) * m4; }
                f32x4 o = v;
                if (s >= 13) {
                    f32x4 pr; pr.x = __shfl_xor(v.x, 8); pr.y = __shfl_xor(v.y, 8); pr.z = __shfl_xor(v.z, 8); pr.w = __shfl_xor(v.w, 8);
                    const int d = col & 63, i0 = d & 31;
                    const f32x4 cs01 = *(const f32x4*)(rope + t * 32 + i0), cs23 = *(const f32x4*)(rope + t * 32 + i0 + 2);
                    const f32x4 cs = (f32x4){cs01.x, cs01.z, cs23.x, cs23.z}, sn = (f32x4){cs01.y, cs01.w, cs23.y, cs23.w};
                    o = (d < 32) ? (v * cs - pr * sn) : (v * cs + pr * sn);
                }
                if (col < 2048 + 1024) {
                    const int c = col - 2048; *(f32x4*)(V0 + (size_t)m * 1024 + c) = v;
                    if (l > 0) { v2u w; w.x = pk2(v.x, v.y); w.y = pk2(v.z, v.w); *(v2u*)(VB + (size_t)m * 1024 + c) = w; }
                } else if (col < 3168) {
                    const int c = col - 3072; v2u w; w.x = pk2(tanhf(v.x), tanhf(v.y)); w.y = pk2(tanhf(v.z), tanhf(v.w)); *(v2u*)(LA + (size_t)m * 256 + c) = w;
                } else if (col < 3264) {
                    const int c = col - 3168; v2u w; w.x = pk2(v.x, v.y); w.y = pk2(v.z, v.w); *(v2u*)(LA + (size_t)(MTOK + m) * 256 + c) = w;
                } else if (col < 3520) {
                    const int c = col - 3264; v2u w; w.x = pk2(sigmoidf_(v.x), sigmoidf_(v.y)); w.y = pk2(sigmoidf_(v.z), sigmoidf_(v.w)); *(v2u*)(LA + (size_t)(2 * MTOK + m) * 256 + c) = w;
                } else {
                    const int ci = col - 3520;
                    if (ci < 1024) { v2u w; w.x = pk2(o.x * 0.125f, o.y * 0.125f); w.y = pk2(o.z * 0.125f, o.w * 0.125f); *(v2u*)(QN + (size_t)m * 1024 + ci) = w; }
                    else if (ci < 2560) {
                        const int r = (ci - 1024) >> 8, cc = (ci - 1024) & 255, g = cc >> 6, d = cc & 63;
                        const size_t hm = ((size_t)((b * 4 + g) * 2048 + t)) * 64 + d;
                        if (r == 0) { v2u w; w.x = pk2(o.x, o.y); w.y = pk2(o.z, o.w); *(v2u*)(KCH + hm) = w; }
                        else if (r == 1) { v2u w; w.x = pk2(v.x, v.y); w.y = pk2(v.z, v.w); *(v2u*)(VCH + hm) = w; }
                        else if (r == 2) { v2u w; w.x = pk2(o.x, o.y); w.y = pk2(o.z, o.w); *(v2u*)(KS + hm) = w; }
                        else if (r == 4) { v2u w; w.x = pk2(o.x, o.y); w.y = pk2(o.z, o.w); *(v2u*)(KW + hm) = w; }
                        else { const int which = (r == 3) ? 0 : 1; LAS bf16* sp = stT + (size_t)(which * 256 + cc) * 40 + tl;
                            const unsigned w0 = pk2(v.x, v.y), w1 = pk2(v.z, v.w);
                            sp[0] = (bf16)(w0 & 0xffffu); sp[40] = (bf16)(w0 >> 16); sp[80] = (bf16)(w1 & 0xffffu); sp[120] = (bf16)(w1 >> 16); }
                    } else if (ci < 2608) { const int c = ci - 2560; *(f32x4*)(GATE + (size_t)m * 48 + c) = (f32x4){sigmoidf_(v.x), sigmoidf_(v.y), sigmoidf_(v.z), sigmoidf_(v.w)}; }
                }
            }
            if (lane < 20) *(v4u*)(LA + (size_t)m * 256 + 96 + 8 * lane) = (v4u){0u, 0u, 0u, 0u};
            else if (lane >= 32 && lane < 52) *(v4u*)(LA + (size_t)(MTOK + m) * 256 + 96 + 8 * (lane - 32)) = (v4u){0u, 0u, 0u, 0u};
        }
        __syncthreads();
#pragma unroll
        for (int i = 0; i < 4; ++i) { const int idx = F.tid + 512 * i, which = idx >> 10, cc = (idx >> 2) & 255, piece = idx & 3, g = cc >> 6, d = cc & 63;
            const v4u val = *(const LAS v4u*)(stT + (size_t)(which * 256 + cc) * 40 + piece * 8);
            bf16* dst = (which ? VWT : VST) + ((size_t)((b * 4 + g) * 64 + d)) * 2048 + tbase + piece * 8;
            *(v4u*)dst = val; }
        __syncthreads();
    }
}
using pg8::Unit;
struct FStoreF32 { float* O; int ldc;
    __device__ __forceinline__ void operator()(const Unit&, int row, int col, f32x4 v) const { *(f32x4*)(O + (size_t)row * ldc + col) = v; } };
struct FLora { float* WD; float* AA; float* GG; const float* w0; const float* a0;
    __device__ __forceinline__ void operator()(const Unit& u, int row, int col, f32x4 v) const {
        const int s = u.pn >> 2, tok = row - s * MTOK, c = col - s * 1024; const size_t o = (size_t)tok * 1024 + c;
        if (s == 0) { const f32x4 b = *(const f32x4*)(w0 + c); f32x4 r;
#pragma unroll
            for (int i = 0; i < 4; ++i) { const float x = b[i] + v[i]; const float sg = 1.0f / (1.0f + __expf(-x)); r[i] = __expf(-0.6065306597126334f * sg); }
            *(f32x4*)(WD + o) = r; }
        else if (s == 1) { const f32x4 b = *(const f32x4*)(a0 + c); f32x4 r;
#pragma unroll
            for (int i = 0; i < 4; ++i) r[i] = 1.0f / (1.0f + __expf(-(b[i] + v[i])));
            *(f32x4*)(AA + o) = r; }
        else *(f32x4*)(GG + o) = v;
    } };
struct FStoreBf8 { bf16* O; int ldc;
    __device__ __forceinline__ void operator()(const Unit&, int row, int col, f32x4 v0, f32x4 v1) const {
        v4u w; w.x = pk2(v0.x, v0.y); w.y = pk2(v0.z, v0.w); w.z = pk2(v1.x, v1.y); w.w = pk2(v1.z, v1.w); *(v4u*)(O + (size_t)row * ldc + col) = w; } };
__device__ __forceinline__ float gelu_tanh(float x) { const float u = 0.7978845608028654f * (x + 0.044715f * x * x * x); return x / (1.0f + __expf(-2.0f * u)); }
struct FCmp1 { bf16* CH; const float* B1;
    __device__ __forceinline__ void operator()(const Unit& u, int row, int col, f32x4 v0, f32x4 v1) const {
        const int j = u.pm >> 3, ci = col - j * 256; const f32x4 b0 = *(const f32x4*)(B1 + j * 256 + ci), b1 = *(const f32x4*)(B1 + j * 256 + ci + 4);
        v0 = v0 + b0; v1 = v1 + b1; v4u w; w.x = pk2(gelu_tanh(v0.x), gelu_tanh(v0.y)); w.y = pk2(gelu_tanh(v0.z), gelu_tanh(v0.w)); w.z = pk2(gelu_tanh(v1.x), gelu_tanh(v1.y)); w.w = pk2(gelu_tanh(v1.z), gelu_tanh(v1.w));
        *(v4u*)(CH + (size_t)row * 256 + ci) = w; } };
struct FV2 { float* V; const float* VF; const float* v0;
    __device__ __forceinline__ void operator()(const Unit&, int row, int col, f32x4 acc) const {
        const size_t o = (size_t)row * 1024 + col; const f32x4 v = *(const f32x4*)(V + o), vf = *(const f32x4*)(VF + o), b = *(const f32x4*)(v0 + col); f32x4 r;
#pragma unroll
        for (int i = 0; i < 4; ++i) { const float s = 1.0f / (1.0f + __expf(-(b[i] + acc[i]))); r[i] = v[i] + (vf[i] - v[i]) * s; }
        *(f32x4*)(V + o) = r; } };
struct FCmp2 { bf16* KC; bf16* VCT;
    __device__ __forceinline__ void operator()(const Unit& u, int row, int col, f32x4 v) const {
        const int j = u.pm >> 3, ci = col - j * 256; if (ci >= 64) return;
        const int rr = row - j * 2048, bg = rr >> 7, c = rr & 127;
        if (j == 0) { v2u w; w.x = pk2(v.x, v.y); w.y = pk2(v.z, v.w); *(v2u*)(KC + (size_t)(bg * 128 + c) * 64 + ci) = w; }
        else { const unsigned w0 = pk2(v.x, v.y), w1 = pk2(v.z, v.w); bf16* p = VCT + (size_t)(bg * 64 + ci) * 128 + c;
            p[0] = (bf16)(w0 & 0xffffu); p[128] = (bf16)(w0 >> 16); p[256] = (bf16)(w1 & 0xffffu); p[384] = (bf16)(w1 >> 16); }
    } };
struct FResid { float* Z; const float* X; const float* gt;
    __device__ __forceinline__ void operator()(const Unit&, int row, int col, f32x4 acc) const {
        const int b = row >> 11; const size_t o = (size_t)row * DM + col; const f32x4 x = *(const f32x4*)(X + o), g = *(const f32x4*)(gt + (size_t)b * 12288 + col);
        *(f32x4*)(Z + o) = x * DN_ALPHA + (g + 1.0f) * acc; } };
struct FRelu2 { bf16* O;
    __device__ __forceinline__ void operator()(const Unit&, int row, int col, f32x4 v0, f32x4 v1) const {
        f32x4 a, b;
#pragma unroll
        for (int i = 0; i < 4; ++i) { const float x = v0[i] > 0.f ? v0[i] : 0.f, y = v1[i] > 0.f ? v1[i] : 0.f; a[i] = x * x; b[i] = y * y; }
        v4u w; w.x = pk2(a.x, a.y); w.y = pk2(a.z, a.w); w.z = pk2(b.x, b.y); w.w = pk2(b.z, b.w); *(v4u*)(O + (size_t)row * DFF + col) = w; } };

constexpr int SC_TC = 32, SC_BUF_FLOATS = 5 * SC_TC * 64 + SC_TC * 16;
__device__ __forceinline__ void phase_scan(Frame& F, const Args& a, int l) {
    const float* U = (const float*)(F.ws + WS_U); const float* mu = a.in[5] + (size_t)l * RWKV_COLS;
    const float* WD = (const float*)(F.ws + WS_WD); const float* AA = (const float*)(F.ws + WS_AA); const float* VV = (const float*)(F.ws + (l == 0 ? WS_VF : WS_V));
    const float* k_kp = a.in[11] + l * 1024; const float* k_ap = a.in[12] + l * 1024; const float* r_kp = a.in[13] + l * 1024;
    float* OS = (float*)(F.ws + WS_OS); float* BON = (float*)(F.ws + WS_BONUS);
    LAS float* buf = (LAS float*)F.lds;
    const int lane = F.lane, w = F.wave, rl = lane >> 4, kq = lane & 15, tid2 = F.tid - 256;
    for (int it = F.vcu; it < 256; it += F.G) {
        const int bh = it >> 2, q4 = it & 3, b = bh >> 4, h = bh & 15; const size_t m0 = (size_t)b * 2048; const int col0 = h * 64;
        __syncthreads();
        if (w >= 4) {
            const int f4 = tid2 & 15, cc = col0 + 4 * f4;
            const f32x4 mur = *(const f32x4*)(mu + cc), muk = *(const f32x4*)(mu + 1024 + cc), kkp = *(const f32x4*)(k_kp + cc), kap = *(const f32x4*)(k_ap + cc), rkp = *(const f32x4*)(r_kp + cc);
#define SC_LOAD(c) do { LAS float* bb = buf + ((c) % 3) * SC_BUF_FLOATS; const int tc0 = (c) * SC_TC; \
            _Pragma("unroll") for (int i = 0; i < 2; ++i) { const int st = (tid2 >> 4) + 16 * i, t = tc0 + st; const size_t m = m0 + t; const float* ur = U + m * NINP + cc; \
                f32x4 ru = *(const f32x4*)ur, ku = *(const f32x4*)(ur + 1024), rp = (f32x4){0.f, 0.f, 0.f, 0.f}, kp = rp; \
                if (t > 0) { rp = *(const f32x4*)(ur - NINP); kp = *(const f32x4*)(ur - NINP + 1024); } \
                const f32x4 aa = *(const f32x4*)(AA + m * 1024 + cc), wd = *(const f32x4*)(WD + m * 1024 + cc); \
                const f32x4 r4 = ru + (rp - ru) * mur, k4 = ku + (kp - ku) * muk; const f32x4 kr = k4 * kkp; \
                const float ss = row16_sum((kr.x * kr.x + kr.y * kr.y) + (kr.z * kr.z + kr.w * kr.w)); \
                const float inv = 1.0f / fmaxf(sqrtf(ss), 1e-12f); const f32x4 kk = kr * inv; const f32x4 km = k4 * ((aa - 1.0f) * kap + 1.0f); \
                const f32x4 pr = r4 * km * rkp; const float bon = row16_sum((pr.x + pr.y) + (pr.z + pr.w)); \
                if (q4 == 0 && f4 == 0) BON[m * 16 + h] = bon; \
                *(LAS f32x4*)(bb + (0 * SC_TC + st) * 64 + 4 * f4) = wd; *(LAS f32x4*)(bb + (1 * SC_TC + st) * 64 + 4 * f4) = kk; *(LAS f32x4*)(bb + (2 * SC_TC + st) * 64 + 4 * f4) = kk * aa; \
                *(LAS f32x4*)(bb + (3 * SC_TC + st) * 64 + 4 * f4) = km; *(LAS f32x4*)(bb + (4 * SC_TC + st) * 64 + 4 * f4) = r4; } \
            if (tid2 < 128) { const int st = tid2 >> 2, g4_ = tid2 & 3; *(LAS f32x4*)(bb + 5 * SC_TC * 64 + st * 16 + 4 * g4_) = *(const f32x4*)(VV + (m0 + tc0 + st) * 1024 + col0 + 16 * q4 + 4 * g4_); } } while (0)
            SC_LOAD(0); SC_LOAD(1);
            for (int c = 0; c < SEQ / SC_TC; ++c) { __syncthreads(); if (c + 2 < SEQ / SC_TC) SC_LOAD(c + 2); }
#undef SC_LOAD
        } else {
            float s0 = 0.f, s1 = 0.f, s2 = 0.f, s3 = 0.f, okeep = 0.f;
            for (int c = 0; c < SEQ / SC_TC; ++c) {
                __syncthreads();
                const LAS float* bb = buf + (c % 3) * SC_BUF_FLOATS + 4 * kq; const LAS float* bv = buf + (c % 3) * SC_BUF_FLOATS + 5 * SC_TC * 64 + 4 * w + rl;
                float* op = OS + (m0 + (size_t)c * SC_TC + kq) * 1024 + col0 + 16 * q4 + 4 * w + rl;
                f32x4 W4[3], K4[3], B4[3], M4[3], R4[3]; float V1[3];
#define SC_FETCH(st) do { W4[(st) % 3] = *(const LAS f32x4*)(bb + (0 * SC_TC + (st)) * 64); K4[(st) % 3] = *(const LAS f32x4*)(bb + (1 * SC_TC + (st)) * 64); B4[(st) % 3] = *(const LAS f32x4*)(bb + (2 * SC_TC + (st)) * 64); \
                M4[(st) % 3] = *(const LAS f32x4*)(bb + (3 * SC_TC + (st)) * 64); R4[(st) % 3] = *(const LAS f32x4*)(bb + (4 * SC_TC + (st)) * 64); V1[(st) % 3] = bv[(st) * 16]; } while (0)
                SC_FETCH(0); SC_FETCH(1);
#pragma unroll
                for (int st = 0; st < SC_TC; ++st) {
                    if (st + 2 < SC_TC) SC_FETCH(st + 2);
                    const f32x4 w4 = W4[st % 3], kk4 = K4[st % 3], b4 = B4[st % 3], k4 = M4[st % 3], r4 = R4[st % 3]; const float vv = V1[st % 3];
                    float d = (s0 * kk4.x + s1 * kk4.y) + (s2 * kk4.z + s3 * kk4.w); d = row16_sum(d);
                    s0 = s0 * w4.x + (vv * k4.x - d * b4.x); s1 = s1 * w4.y + (vv * k4.y - d * b4.y); s2 = s2 * w4.z + (vv * k4.z - d * b4.z); s3 = s3 * w4.w + (vv * k4.w - d * b4.w);
                    float o = (s0 * r4.x + s1 * r4.y) + (s2 * r4.z + s3 * r4.w); o = row16_sum(o);
                    okeep = ((st & 15) == kq) ? o : okeep;
                    if ((st & 15) == 15) op[(size_t)(st & 16) * 1024] = okeep;
                }
#undef SC_FETCH
            }
        }
    }
    __syncthreads();
}

constexpr int AT_KSTR = 72;
constexpr int AT_TILE = 64 * AT_KSTR;
struct AttnState { f32x4 O[4][4]; float m[4], l[4]; };
__device__ __forceinline__ float hmax4(f32x4 v) { return fmaxf(fmaxf(v.x, v.y), fmaxf(v.z, v.w)); }
template <int MODE>
__device__ __forceinline__ void attn_half(AttnState& st, const bf16x8 (&qf)[4][2], const LAS bf16* Kt, const LAS bf16* Vt, int a, int keybase, int t, unsigned selmask,
                                          const float (&mfin)[4], const float (&linv)[4], f32x4 (&psum)[2], int lane) {
    asm volatile("" : "+v"(lane));
    const int kr = lane & 15, g4 = lane >> 4;
    bf16x8 kf[2][2];
#pragma unroll
    for (int ds = 0; ds < 2; ++ds)
#pragma unroll
        for (int x = 0; x < 2; ++x) kf[ds][x] = *(const LAS bf16x8*)(Kt + (32 * a + 16 * x + kr) * AT_KSTR + 32 * ds + 8 * g4);
    bool val[2][4];
#pragma unroll
    for (int x = 0; x < 2; ++x)
#pragma unroll
        for (int r = 0; r < 4; ++r) { const int key = keybase + 32 * a + 16 * x + 4 * g4 + r;
            if (MODE <= 1) val[x][r] = (16 * key + 31) <= t;
            else if (MODE == 2) val[x][r] = (key <= t) && ((selmask >> (key >> 6)) & 1u);
            else val[x][r] = (key <= t) && (t - key < 512); }
    bf16x8 pb[4];
#pragma unroll
    for (int hh = 0; hh < 4; ++hh) {
        f32x4 s0 = (f32x4){0.f, 0.f, 0.f, 0.f}, s1 = (f32x4){0.f, 0.f, 0.f, 0.f};
#pragma unroll
        for (int ds = 0; ds < 2; ++ds) { s0 = __builtin_amdgcn_mfma_f32_16x16x32_bf16(kf[ds][0], qf[hh][ds], s0, 0, 0, 0); s1 = __builtin_amdgcn_mfma_f32_16x16x32_bf16(kf[ds][1], qf[hh][ds], s1, 0, 0, 0); }
#pragma unroll
        for (int r = 0; r < 4; ++r) { if (!val[0][r]) s0[r] = NEGBIG; if (!val[1][r]) s1[r] = NEGBIG; }
        f32x4 p0, p1;
        if (MODE == 1) {
#pragma unroll
            for (int r = 0; r < 4; ++r) { p0[r] = val[0][r] ? __expf(s0[r] - mfin[hh]) * linv[hh] : 0.f; p1[r] = val[1][r] ? __expf(s1[r] - mfin[hh]) * linv[hh] : 0.f; }
            psum[0] += p0; psum[1] += p1;
        } else {
            float mloc = fmaxf(hmax4(s0), hmax4(s1));
            mloc = fmaxf(mloc, __shfl_xor(mloc, 16)); mloc = fmaxf(mloc, __shfl_xor(mloc, 32));
            const float mnew = fmaxf(st.m[hh], mloc); const float alpha = __expf(st.m[hh] - mnew);
#pragma unroll
            for (int r = 0; r < 4; ++r) { p0[r] = val[0][r] ? __expf(s0[r] - mnew) : 0.f; p1[r] = val[1][r] ? __expf(s1[r] - mnew) : 0.f; }
            st.l[hh] = st.l[hh] * alpha + ((p0.x + p0.y) + (p0.z + p0.w)) + ((p1.x + p1.y) + (p1.z + p1.w));
            st.m[hh] = mnew;
            if (MODE != 0) {
#pragma unroll
                for (int dt = 0; dt < 4; ++dt) st.O[hh][dt] = st.O[hh][dt] * alpha;
            }
        }
        if (MODE != 0) {
            v4u w; w.x = pk2(p0.x, p0.y); w.y = pk2(p0.z, p0.w); w.z = pk2(p1.x, p1.y); w.w = pk2(p1.z, p1.w);
            pb[hh] = __builtin_bit_cast(bf16x8, w);
        }
        __builtin_amdgcn_sched_barrier(0);
    }
    if (MODE != 0) {
#pragma unroll
        for (int dt = 0; dt < 4; ++dt) {
            const v2u lo = *(const LAS v2u*)(Vt + (16 * dt + kr) * AT_KSTR + 32 * a + 4 * g4);
            const v2u hi = *(const LAS v2u*)(Vt + (16 * dt + kr) * AT_KSTR + 32 * a + 16 + 4 * g4);
            const v4u vv = (v4u){lo.x, lo.y, hi.x, hi.y}; const bf16x8 vf = __builtin_bit_cast(bf16x8, vv);
#pragma unroll
            for (int hh = 0; hh < 4; ++hh) st.O[hh][dt] = __builtin_amdgcn_mfma_f32_16x16x32_bf16(vf, pb[hh], st.O[hh][dt], 0, 0, 0);
        }
    }
}
__device__ __forceinline__ void attn_reset(AttnState& st) {
#pragma unroll
    for (int hh = 0; hh < 4; ++hh) { st.m[hh] = NEGBIG; st.l[hh] = 0.f;
#pragma unroll
        for (int dt = 0; dt < 4; ++dt) st.O[hh][dt] = (f32x4){0.f, 0.f, 0.f, 0.f}; }
}
template <int STAGE>
__device__ __forceinline__ void attn_store(AttnState& st, float* ACC, bf16* MIX, const float* GATE, size_t m, int g, int lane) {
    const int g4 = lane >> 4;
#pragma unroll
    for (int hh = 0; hh < 4; ++hh) {
        float sc = GATE[m * 48 + (g * 4 + hh) * 3 + STAGE];
        if (STAGE != 0) { float lt = st.l[hh]; lt += __shfl_xor(lt, 16); lt += __shfl_xor(lt, 32); sc = lt > 0.f ? sc / lt : 0.f; }
#pragma unroll
        for (int dt = 0; dt < 4; ++dt) { const size_t o = m * 1024 + (g * 4 + hh) * 64 + 16 * dt + 4 * g4; f32x4 v = st.O[hh][dt] * sc;
            if (STAGE != 0) v = v + *(const f32x4*)(ACC + o);
            if (STAGE != 2) *(f32x4*)(ACC + o) = v;
            else { v2u w; w.x = pk2(v.x, v.y); w.y = pk2(v.z, v.w); *(v2u*)(MIX + m * DM + 1024 + (g * 4 + hh) * 64 + 16 * dt + 4 * g4) = w; } }
    }
}
__device__ __forceinline__ void phase_nsa(Frame& F) {
    const bf16* QN = (const bf16*)(F.ws + WS_QN); const bf16* KS = (const bf16*)(F.ws + WS_KS); const bf16* KW = (const bf16*)(F.ws + WS_KW);
    const bf16* VST = (const bf16*)(F.ws + WS_VST); const bf16* VWT = (const bf16*)(F.ws + WS_VWT); const bf16* KC = (const bf16*)(F.ws + WS_KC); const bf16* VCT = (const bf16*)(F.ws + WS_VCT);
    float* ACC = (float*)(F.ws + WS_OCMP); bf16* MIX = (bf16*)(F.ws + WS_MIX); const float* GATE = (const float*)(F.ws + WS_GATE);
    LAS bf16* Kt = (LAS bf16*)F.lds; LAS bf16* Vt = Kt + 2 * AT_TILE;
    const int lane = F.lane, w = F.wave, qc = lane & 15, g4 = lane >> 4;
    const int srow = F.tid >> 3, spiece = F.tid & 7;
    for (int item = F.vcu; item < 256; item += F.G) {
        const int bg = item >> 4, qb = 15 - (item & 15), b = bg >> 2, g = bg & 3;
        const int q0 = qb * 128, t0 = q0 + 16 * w, t = t0 + qc; const size_t m = (size_t)b * 2048 + t;
        bf16x8 qf[4][2];
#pragma unroll
        for (int hh = 0; hh < 4; ++hh)
#pragma unroll
            for (int ds = 0; ds < 2; ++ds) qf[hh][ds] = *(const bf16x8*)(QN + m * 1024 + (g * 4 + hh) * 64 + 32 * ds + 8 * g4);
        AttnState st; unsigned selmask = 0u;
        float mfin[4] = {0.f, 0.f, 0.f, 0.f}, linv[4] = {0.f, 0.f, 0.f, 0.f}; f32x4 psd[2];
        __syncthreads();
#pragma unroll
        for (int jj = 0; jj < 2; ++jj) {
            *(LAS v4u*)(Kt + jj * AT_TILE + srow * AT_KSTR + spiece * 8) = *(const v4u*)(KC + ((size_t)(bg * 128 + 64 * jj + srow)) * 64 + spiece * 8);
            *(LAS v4u*)(Vt + jj * AT_TILE + srow * AT_KSTR + spiece * 8) = *(const v4u*)(VCT + ((size_t)(bg * 64 + srow)) * 128 + 64 * jj + spiece * 8);
        }
        __syncthreads();
        attn_reset(st);
#pragma unroll
        for (int jj = 0; jj < 2; ++jj)
#pragma unroll
            for (int a = 0; a < 2; ++a) attn_half<0>(st, qf, Kt + jj * AT_TILE, Vt + jj * AT_TILE, a, 64 * jj, t, 0u, mfin, linv, psd, lane);
#pragma unroll
        for (int hh = 0; hh < 4; ++hh) { float lt = st.l[hh]; lt += __shfl_xor(lt, 16); lt += __shfl_xor(lt, 32); mfin[hh] = st.m[hh]; linv[hh] = lt > 0.f ? 1.0f / lt : 0.f; }
        attn_reset(st);
        float imp[8]; float aprev = 0.f; const int cur = t >> 6; const int srcl = (lane + 48) & 63;
#pragma unroll
        for (int jj = 0; jj < 2; ++jj)
#pragma unroll
            for (int a = 0; a < 2; ++a) { f32x4 pp[2]; pp[0] = (f32x4){0.f, 0.f, 0.f, 0.f}; pp[1] = pp[0];
                attn_half<1>(st, qf, Kt + jj * AT_TILE, Vt + jj * AT_TILE, a, 64 * jj, t, 0u, mfin, linv, pp, lane);
#pragma unroll
                for (int x = 0; x < 2; ++x) { const int kt = 4 * jj + 2 * a + x; const float x3 = pp[x].w; const float up = __shfl(x3, srcl); const float prev3 = (g4 != 0) ? up : aprev; aprev = up;
                    const float v = pp[x].x + pp[x].y + pp[x].z + 0.5f * pp[x].w + 0.5f * prev3;
                    const int blk = 4 * kt + g4; const bool forced = (blk == 0) || (blk == cur) || (blk == cur - 1); const bool causal = blk <= cur;
                    imp[kt] = forced ? 1e4f : (causal ? v : -1.0f); } }
        attn_store<0>(st, ACC, MIX, GATE, m, g, lane);
        {
          unsigned taken = 0u;
#pragma unroll 1
          for (int round = 0; round < 8; ++round) {
              float bv = -3.0e38f; int bi = 1024;
#pragma unroll
              for (int kt = 0; kt < 8; ++kt) { const bool free_ = !((taken >> kt) & 1u); if (free_ && imp[kt] > bv) { bv = imp[kt]; bi = 4 * kt + g4; } }
#pragma unroll
              for (int off = 16; off <= 32; off <<= 1) { const float ov = __shfl_xor(bv, off); const int oi = __shfl_xor(bi, off); if (ov > bv || (ov == bv && oi < bi)) { bv = ov; bi = oi; } }
              selmask |= 1u << (bi & 31);
              if ((bi & 3) == g4) taken |= 1u << (bi >> 2);
          } }
        attn_reset(st);
        { const int jhi = (q0 >> 6) + 1;
          v4u kreg = *(const v4u*)(KS + ((size_t)(bg * 2048 + srow)) * 64 + spiece * 8), vreg = *(const v4u*)(VST + ((size_t)(bg * 64 + srow)) * 2048 + spiece * 8);
          for (int j = 0; j <= jhi; ++j) {
              __syncthreads();
              *(LAS v4u*)(Kt + srow * AT_KSTR + spiece * 8) = kreg; *(LAS v4u*)(Vt + srow * AT_KSTR + spiece * 8) = vreg;
              __syncthreads();
              if (j < jhi) { kreg = *(const v4u*)(KS + ((size_t)(bg * 2048 + 64 * (j + 1) + srow)) * 64 + spiece * 8); vreg = *(const v4u*)(VST + ((size_t)(bg * 64 + srow)) * 2048 + 64 * (j + 1) + spiece * 8); }
              const bool need = (64 * j <= t0 + 15) && (__ballot((selmask >> j) & 1u) != 0ull);
              if (need) {
#pragma unroll
                  for (int a = 0; a < 2; ++a) attn_half<2>(st, qf, Kt, Vt, a, 64 * j, t, selmask, mfin, linv, psd, lane);
              }
          } }
        attn_store<1>(st, ACC, MIX, GATE, m, g, lane);
        attn_reset(st);
        { const int jlo = q0 >= 512 ? ((q0 - 512) >> 6) : 0, jhi = (q0 >> 6) + 1;
          v4u kreg = *(const v4u*)(KW + ((size_t)(bg * 2048 + 64 * jlo + srow)) * 64 + spiece * 8), vreg = *(const v4u*)(VWT + ((size_t)(bg * 64 + srow)) * 2048 + 64 * jlo + spiece * 8);
          for (int j = jlo; j <= jhi; ++j) {
              __syncthreads();
              *(LAS v4u*)(Kt + srow * AT_KSTR + spiece * 8) = kreg; *(LAS v4u*)(Vt + srow * AT_KSTR + spiece * 8) = vreg;
              __syncthreads();
              if (j < jhi) { kreg = *(const v4u*)(KW + ((size_t)(bg * 2048 + 64 * (j + 1) + srow)) * 64 + spiece * 8); vreg = *(const v4u*)(VWT + ((size_t)(bg * 64 + srow)) * 2048 + 64 * (j + 1) + spiece * 8); }
              const bool need = (64 * j <= t0 + 15) && (64 * j + 63 >= t0 - 511);
              if (need) {
#pragma unroll
                  for (int a = 0; a < 2; ++a) attn_half<3>(st, qf, Kt, Vt, a, 64 * j, t, 0u, mfin, linv, psd, lane);
              }
          } }
        attn_store<2>(st, ACC, MIX, GATE, m, g, lane);
    }
    __syncthreads();
}
__device__ __forceinline__ void phase_mixprep(Frame& F, const Args& a, int l) {
    const int gw = F.vcu * NWAVES + F.wave, NGW = F.G * NWAVES, lane = F.lane;
    const float* OS = (const float*)(F.ws + WS_OS); const float* GG = (const float*)(F.ws + WS_GG); const float* VV = (const float*)(F.ws + (l == 0 ? WS_VF : WS_V));
    const float* BON = (const float*)(F.ws + WS_BONUS); const float* lg = a.in[14] + l * 1024; const float* lb = a.in[15] + l * 1024;
    bf16* MIX = (bf16*)(F.ws + WS_MIX);
    for (int m = gw; m < MTOK; m += NGW) {
        const int h = lane >> 2; f32x4 o4[4]; float s = 0.f;
#pragma unroll
        for (int q = 0; q < 4; ++q) { o4[q] = *(const f32x4*)(OS + (size_t)m * 1024 + 16 * lane + 4 * q); s += (o4[q].x + o4[q].y) + (o4[q].z + o4[q].w); }
        const float mean = quad_sum(s) * (1.0f / 64.0f); float s2 = 0.f;
#pragma unroll
        for (int q = 0; q < 4; ++q) { o4[q] = o4[q] - mean; s2 += (o4[q].x * o4[q].x + o4[q].y * o4[q].y) + (o4[q].z * o4[q].z + o4[q].w * o4[q].w); }
        const float rstd = 1.0f / sqrtf(quad_sum(s2) * (1.0f / 64.0f) + GN_EPS); const float bon = BON[(size_t)m * 16 + h];
#pragma unroll
        for (int q = 0; q < 4; ++q) { const int col = 16 * lane + 4 * q; const size_t o = (size_t)m * 1024 + col;
            const f32x4 r = (o4[q] * rstd * *(const f32x4*)(lg + col) + *(const f32x4*)(lb + col) + *(const f32x4*)(VV + o) * bon) * *(const f32x4*)(GG + o);
            v2u w; w.x = pk2(r.x, r.y); w.y = pk2(r.z, r.w); *(v2u*)(MIX + (size_t)m * DM + col) = w;
}
    }
}
__device__ __forceinline__ void phase_ln(Frame& F, const float* Z, const float* g, const float* bta, float* X, const float* sc0, const float* sh0, bf16* H) {
    const int gw = F.vcu * NWAVES + F.wave, NGW = F.G * NWAVES, lane = F.lane;
    for (int m = gw; m < MTOK; m += NGW) {
        const int b = m >> 11; const float* zr = Z + (size_t)m * DM; f32x4 v[8]; float s = 0.f;
#pragma unroll
        for (int j = 0; j < 8; ++j) { v[j] = *(const f32x4*)(zr + 4 * (lane + 64 * j)); s += (v[j].x + v[j].y) + (v[j].z + v[j].w); }
        const float mean = wave_sum(s) * (1.0f / DM); float s2 = 0.f;
#pragma unroll
        for (int j = 0; j < 8; ++j) { v[j] = v[j] - mean; s2 += (v[j].x * v[j].x + v[j].y * v[j].y) + (v[j].z * v[j].z + v[j].w * v[j].w); }
        const float rstd = 1.0f / sqrtf(wave_sum(s2) * (1.0f / DM) + LN_EPS);
#pragma unroll
        for (int j = 0; j < 8; ++j) { const int col = 4 * (lane + 64 * j);
            const f32x4 x = v[j] * rstd * *(const f32x4*)(g + col) + *(const f32x4*)(bta + col);
            *(f32x4*)(X + (size_t)m * DM + col) = x;
            if (sc0) { const f32x4 h = x * (*(const f32x4*)(sc0 + (size_t)b * 12288 + col) + 1.0f) + *(const f32x4*)(sh0 + (size_t)b * 12288 + col);
                v2u w; w.x = pk2(h.x, h.y); w.y = pk2(h.z, h.w); *(v2u*)(H + (size_t)m * DM + col) = w; } }
    }
}

#define GEMM_CALL(EPI, SCHED, g, S, E) pg8::gemm_phase<EPI, SCHED, true, true>(F.lds, g, S, E)
__global__ void __launch_bounds__(NWAVES * 64, 2) mk_fwd(Args args) {
    extern __shared__ __attribute__((aligned(16))) unsigned char lds[];
    Frame F;
    F.lds = (LAS unsigned char*)lds;
    F.MISC = (volatile LAS unsigned*)(F.lds + MISC_OFF);
    F.tid = threadIdx.x; F.lane = F.tid & 63; F.wave = __builtin_amdgcn_readfirstlane(F.tid >> 6);
    F.G = gridDim.x; { const int bx = blockIdx.x; F.vcu = (F.G % 8 == 0) ? (bx % 8) * (F.G / 8) + bx / 8 : bx; }
    F.ws = (GAS unsigned char*)args.ws; F.ctl = (gu32*)(F.ws + WS_CTL);
    for (int u = F.tid; u < (LDS_BYTES - LDSCTL_OFF) / 4; u += NWAVES * 64) ((LAS unsigned*)(F.lds + LDSCTL_OFF))[u] = 0u;
    __syncthreads();
    XcdBarrier bar; bar.bar = (unsigned*)(F.ctl + CW_BAR); bar.x = 0; bar.st = nullptr;
    if (!MK_PER_PHASE) bar = xcd_barrier_post((unsigned*)(F.ctl + CW_BAR), F.MISC + 8);
    const int lo = args.ph_lo, hi = args.ph_hi;
#ifndef MK_SUB
#define MK_SUB 31
#endif
#ifndef MK_PHASE_MASK
#define MK_PHASE_MASK 0x7fff
#endif
#define PH_ON(j) (((MK_PHASE_MASK) >> (j)) & 1)
#ifndef MK_REPEAT
#define MK_REPEAT 0
#endif
#define REP(j) for (int rep_ = 0; rep_ < 1 + (((MK_REPEAT) >> (j)) & 1); ++rep_)
#define IN(k) (lo <= (k) && (k) < hi)
#define SEAM(k) do { if (IN((k) + 1)) xcd_barrier(bar); } while (0)
#define REFRESH() do { asm volatile("" : "+v"(F.tid)); F.lane = F.tid & 63; F.wave = __builtin_amdgcn_readfirstlane(F.tid >> 6); asm volatile("" : "+s"(F.vcu)); asm volatile("" : "+s"(F.ws)); } while (0)
    const int bx = (int)blockIdx.x, G = F.G;

    if (PH_ON(0) && IN(0)) { REFRESH(); REP(0) phase_pre0(F, args); SEAM(0); }
    if (PH_ON(1) && IN(1)) { REFRESH(); phase_pre1(F, args); SEAM(1); }

    for (int l = 0; l < DEPTH; ++l) {
        const int pb = 2 + 13 * l;
        GAS unsigned char* wl = wlayer(F, l);
        const float* Xin = (l == 0) ? args.in[0] : (const float*)(F.ws + WS_XA);
        if (PH_ON(2) && IN(pb + 0)) { REFRESH();
            pg8::Gemm g{(const bf16*)(F.ws + WS_H), (const bf16*)(wl + WL_IN), DM, DM, DM}; pg8::StaticOrder S; S.init(MTOK, NINP, G, bx);
            pg8::EpiF4<FStoreF32> E{{(float*)(F.ws + WS_U), NINP}};
            REP(2) GEMM_CALL(pg8::EpiF4<FStoreF32>, pg8::StaticOrder, g, S, E);
            SEAM(pb + 0);
        }
        if (PH_ON(3) && IN(pb + 1)) { REFRESH(); REP(3) phase_prep(F, args, l); SEAM(pb + 1); }
        if (PH_ON(4) && IN(pb + 2)) { REFRESH(); REP(4) {
            if (MK_SUB & 1) { pg8::Gemm g{(const bf16*)(F.ws + WS_KCH), (const bf16*)(wl + WL_C1), 2048, 1024, 2048}; pg8::ListOrder S{16, G, bx, 2};
              pg8::EpiF8<FCmp1> E{{(bf16*)(F.ws + WS_CH), (const float*)(F.ws + WS_B1) + l * 512}};
              GEMM_CALL(pg8::EpiF8<FCmp1>, pg8::ListOrder, g, S, E); }
            if ((MK_SUB & 2) && l > 0) { pg8::Gemm g{(const bf16*)(F.ws + WS_VB), (const bf16*)(wl + WL_V1), 1024, 1024, 1024}; pg8::ListOrder S{32, G, (bx + G - 16) % G, 1};
              pg8::EpiF8<FStoreBf8> E{{(bf16*)(F.ws + WS_V1O), 256}};
              GEMM_CALL(pg8::EpiF8<FStoreBf8>, pg8::ListOrder, g, S, E); }
            if (MK_SUB & 4) { pg8::Gemm g{(const bf16*)(F.ws + WS_LA), (const bf16*)(wl + WL_LORA), 256, 256, 256}; pg8::ListOrder S{384, G, (bx + G - 48) % G, 0};
              pg8::EpiF4<FLora> E{{(float*)(F.ws + WS_WD), (float*)(F.ws + WS_AA), (float*)(F.ws + WS_GG), args.in[6] + l * 1024, args.in[8] + l * 1024}};
              GEMM_CALL(pg8::EpiF4<FLora>, pg8::ListOrder, g, S, E); }
            }
            SEAM(pb + 2);
        }
        if (PH_ON(5) && IN(pb + 3)) { REFRESH();
            if ((MK_SUB & 8) && l > 0) { pg8::Gemm g{(const bf16*)(F.ws + WS_V1O), (const bf16*)(wl + WL_V2), 256, 256, 256}; pg8::ListOrder S{128, G, bx, 3};
              pg8::EpiF4<FV2> E{{(float*)(F.ws + WS_V), (const float*)(F.ws + WS_VF), args.in[16] + (l - 1) * 1024}};
              GEMM_CALL(pg8::EpiF4<FV2>, pg8::ListOrder, g, S, E); }
            if (MK_SUB & 16) { pg8::Gemm g{(const bf16*)(F.ws + WS_CH), (const bf16*)(wl + WL_C2), 256, 256, 256}; pg8::ListOrder S{16, G, (bx + G - 128) % G, 2};
              pg8::EpiF4<FCmp2> E{{(bf16*)(F.ws + WS_KC), (bf16*)(F.ws + WS_VCT)}};
              GEMM_CALL(pg8::EpiF4<FCmp2>, pg8::ListOrder, g, S, E); }
            SEAM(pb + 3);
        }
        if (PH_ON(7) && IN(pb + 5)) { REFRESH(); REP(7) phase_scan(F, args, l); }
        if (PH_ON(8) && IN(pb + 6)) { REFRESH(); REP(8) phase_nsa(F); SEAM(pb + 6); }
        if (PH_ON(9) && IN(pb + 7)) { REFRESH(); REP(9) phase_mixprep(F, args, l); SEAM(pb + 7); }
        if (PH_ON(10) && IN(pb + 8)) { REFRESH();
            pg8::Gemm g{(const bf16*)(F.ws + WS_MIX), (const bf16*)(wl + WL_OUT), DM, DM, DM}; pg8::StaticOrder S; S.init(MTOK, DM, G, bx);
            pg8::EpiF4<FResid> E{{(float*)(F.ws + WS_Z), Xin, modp(F, l, 0, 2)}};
            REP(10) GEMM_CALL(pg8::EpiF4<FResid>, pg8::StaticOrder, g, S, E);
            SEAM(pb + 8);
        }
        if (PH_ON(11) && IN(pb + 9)) { REFRESH(); REP(11) phase_ln(F, (const float*)(F.ws + WS_Z), args.in[23] + l * DM, args.in[24] + l * DM, (float*)(F.ws + WS_XB), modp(F, l, 0, 4), modp(F, l, 0, 3), (bf16*)(F.ws + WS_H)); SEAM(pb + 9); }
        if (PH_ON(12) && IN(pb + 10)) { REFRESH();
            pg8::Gemm g{(const bf16*)(F.ws + WS_H), (const bf16*)(wl + WL_W1), DM, DM, DM}; pg8::StaticOrder S; S.init(MTOK, DFF, G, bx);
            pg8::EpiF8<FRelu2> E{{(bf16*)(F.ws + WS_U)}};
            REP(12) GEMM_CALL(pg8::EpiF8<FRelu2>, pg8::StaticOrder, g, S, E);
            SEAM(pb + 10);
        }
        if (PH_ON(13) && IN(pb + 11)) { REFRESH();
            pg8::Gemm g{(const bf16*)(F.ws + WS_U), (const bf16*)(wl + WL_W2), DFF, DFF, DFF}; pg8::StaticOrder S; S.init(MTOK, DM, G, bx);
            pg8::EpiF4<FResid> E{{(float*)(F.ws + WS_Z), (const float*)(F.ws + WS_XB), modp(F, l, 0, 5)}};
            REP(13) GEMM_CALL(pg8::EpiF4<FResid>, pg8::StaticOrder, g, S, E);
            SEAM(pb + 11);
        }
        if (PH_ON(14) && IN(pb + 12)) { REFRESH();
            const bool lastl = (l == DEPTH - 1);
            REP(14) phase_ln(F, (const float*)(F.ws + WS_Z), args.in[27] + l * DM, args.in[28] + l * DM, lastl ? args.out : (float*)(F.ws + WS_XA),
                     lastl ? nullptr : modp(F, l + 1, 0, 1), lastl ? nullptr : modp(F, l + 1, 0, 0), (bf16*)(F.ws + WS_H));
            if (!lastl) SEAM(pb + 12);
        }
    }
#undef IN
#undef SEAM
}

extern "C" void kernel_launch(void* const* d_in, const int* in_sizes, int n_in, void* d_out, int out_size, void* d_ws, size_t ws_size, hipStream_t stream) {
    static int grid = 0;
    if (grid == 0) {
        if (n_in != 29 || in_sizes[0] != MTOK * DM || out_size != MTOK * DM || ws_size < WS_END) {
            fprintf(stderr, "kernel_launch: unexpected problem: n_in %d in0 %d out %d ws %zu (need %zu); nothing launched\n", n_in, n_in > 0 ? in_sizes[0] : -1, out_size, ws_size, (size_t)WS_END); grid = -1; return; }
        int dev = 0, cus = 0, per_cu = 0;
        if (hipGetDevice(&dev) != hipSuccess || hipDeviceGetAttribute(&cus, hipDeviceAttributeMultiprocessorCount, dev) != hipSuccess) { fprintf(stderr, "kernel_launch: device query failed\n"); grid = -1; return; }
        if (hipFuncSetAttribute((const void*)mk_fwd, hipFuncAttributeMaxDynamicSharedMemorySize, LDS_BYTES) != hipSuccess) { fprintf(stderr, "kernel_launch: hipFuncSetAttribute failed\n"); grid = -1; return; }
        if (hipOccupancyMaxActiveBlocksPerMultiprocessor(&per_cu, (const void*)mk_fwd, NWAVES * 64, LDS_BYTES) != hipSuccess || per_cu < 1)
            fprintf(stderr, "kernel_launch: note: occupancy query reports %d workgroups per CU\n", per_cu);
        (void)hipGetLastError();
        grid = cus;
    }
    if (grid < 0) return;
    if (hipMemsetAsync((char*)d_ws + WS_CTL, 0, CTL_ZERO_BYTES, stream) != hipSuccess) { fprintf(stderr, "kernel_launch: memset failed\n"); return; }
    Args a{};
    for (int i = 0; i < 29; ++i) a.in[i] = (const float*)d_in[i];
    a.out = (float*)d_out; a.ws = (unsigned char*)d_ws;
#if MK_PER_PHASE
    for (int p = 0; p < N_PHASES; ++p) { a.ph_lo = p; a.ph_hi = p + 1; hipLaunchKernelGGL(mk_fwd, dim3(grid), dim3(NWAVES * 64), LDS_BYTES, stream, a); }
#else
    a.ph_lo = 0; a.ph_hi = N_PHASES;
    hipLaunchKernelGGL(mk_fwd, dim3(grid), dim3(NWAVES * 64), LDS_BYTES, stream, a);
#endif
    const hipError_t le = hipPeekAtLastError();
    if (le != hipSuccess) fprintf(stderr, "kernel_launch: launch failed: %s\n", hipGetErrorName(le));
}
```

```cpp
#include <hip/hip_runtime.h>
#include <cstdio>
#include <cstdint>

#ifndef MK_REPEAT
#define MK_REPEAT 0
#endif
#ifndef MK_PER_PHASE
#define MK_PER_PHASE 0
#endif

namespace pg8 {
#define PG8_LAS __attribute__((address_space(3)))
typedef unsigned short bf16_t;
typedef short bf16x8 __attribute__((ext_vector_type(8)));
typedef float f32x4 __attribute__((ext_vector_type(4)));
typedef unsigned u32x4 __attribute__((ext_vector_type(4)));
typedef unsigned u32x2 __attribute__((ext_vector_type(2)));
constexpr int BM = 256, BK = 64, HALF = 128, HTB = HALF * BK * 2  , STAGE_BYTES = 8 * HTB, NXCD = 8, WGM = 8;

__host__ __device__ __forceinline__ int lds_byte(int r, int c) { const int st = (r >> 4) * 2 + (c >> 5), rr = r & 15, cc = c & 31, ob = rr * 64 + cc * 2; return st * 1024 + (ob ^ (((ob >> 9) & 1) << 5)); }
__host__ __device__ __forceinline__ void stage_rc(int b, int& R, int& C) { const int st = b / 1024, sb = b % 1024, swz = sb ^ (((sb >> 9) & 1) << 5); R = (st >> 1) * 16 + swz / 64; C = (st & 1) * 32 + (swz % 64) / 2; }
__host__ __device__ __forceinline__ int perm32(int rho) { const int n = rho >> 4, i = rho & 15; return 8 * (i >> 2) + 4 * n + (i & 3); }

struct Unit { int pm, pn; };
struct Gemm { const bf16_t* A; const bf16_t* Bt; int K, lda, ldb; };

struct StaticOrder {
    int nM, nN, nwg, G, c;
    __host__ __device__ void init(int M, int N, int G_, int c_) { nM = M / BM; nN = N / BM; nwg = nM * nN; G = G_; c = c_; }
    __host__ __device__ bool next(int i, Unit& u) const {
        const long L = (long)i * G + c; if (L >= nwg) return false;
        int wgid = (int)L; { const int q = nwg / NXCD, r = nwg % NXCD, xcd = wgid % NXCD, off = wgid / NXCD; wgid = (xcd < r ? xcd * (q + 1) : r * (q + 1) + (xcd - r) * q) + off; }
        const int nig = WGM * nN, gid = wgid / nig, fm = gid * WGM, gsz = (nM - fm) < WGM ? (nM - fm) : WGM;
        u.pm = fm + ((wgid % nig) % gsz); u.pn = (wgid % nig) / gsz; return true;
    }
    __device__ __forceinline__ void a_ready(const Unit&) const {}
    __device__ __forceinline__ void done(const Unit&) const {}
};
struct ListOrder {
    int n, G, c, kind;
    __device__ bool next(int i, Unit& u) const {
        const int L = i * G + c; if (L >= n) return false;
        if (kind == 0) { const int s = L >> 7, r = L & 127; u.pm = s * 32 + (r & 31); u.pn = s * 4 + (r >> 5); }
        else if (kind == 1) { u.pm = L; u.pn = 0; }
        else if (kind == 2) { u.pm = L; u.pn = L >> 3; }
        else { u.pm = L & 31; u.pn = L >> 5; }
        return true;
    }
    __device__ __forceinline__ void a_ready(const Unit&) const {}
    __device__ __forceinline__ void done(const Unit&) const {}
};

__device__ __forceinline__ unsigned cvt_pk_bf16(float lo, float hi) { unsigned r; asm volatile("v_cvt_pk_bf16_f32 %0, %1, %2" : "=v"(r) : "v"(lo), "v"(hi)); return r; }

template <class F> struct EpiF4 {
    static constexpr bool PERM = false, AFTER_DRAIN = false; F f;
    __device__ __forceinline__ void operator()(const f32x4 (&acc)[2][2][4][2], const Unit& u, int wr, int wc, int fr, int fq) const {
#pragma unroll
        for (int ai = 0; ai < 2; ++ai)
#pragma unroll
            for (int m = 0; m < 4; ++m) { const int row = u.pm * BM + ai * HALF + wr * 64 + m * 16 + fr;
#pragma unroll
                for (int bj = 0; bj < 2; ++bj)
#pragma unroll
                    for (int n = 0; n < 2; ++n) { f(u, row, u.pn * BM + bj * HALF + wc * 32 + 16 * n + 4 * fq, acc[ai][bj][m][n]); asm volatile("" ::: "memory"); } }
    }
};
template <class F> struct EpiF8 {
    static constexpr bool PERM = true, AFTER_DRAIN = false; F f;
    __device__ __forceinline__ void operator()(const f32x4 (&acc)[2][2][4][2], const Unit& u, int wr, int wc, int fr, int fq) const {
#pragma unroll
        for (int ai = 0; ai < 2; ++ai)
#pragma unroll
            for (int m = 0; m < 4; ++m) { const int row = u.pm * BM + ai * HALF + wr * 64 + m * 16 + fr;
#pragma unroll
                for (int bj = 0; bj < 2; ++bj) f(u, row, u.pn * BM + bj * HALF + wc * 32 + 8 * fq, acc[ai][bj][m][0], acc[ai][bj][m][1]);
                asm volatile("" ::: "memory"); }
    }
};

template <class Epi, class Sched, bool ALIGN_EPI = false, bool SP2 = false>
__device__ __forceinline__ void gemm_phase(PG8_LAS unsigned char* lds, int wave_id, const Gemm g, const Sched& S, const Epi& E) {
    unsigned z_ = 0u; asm volatile("" : "+v"(z_)); int tid_ = wave_id * 64 + (int)__builtin_amdgcn_mbcnt_hi(~0u, __builtin_amdgcn_mbcnt_lo(~0u, z_));
    const int tid = tid_, wid = __builtin_amdgcn_readfirstlane(tid >> 6), lane = tid & 63, wr = wid >> 2, wc = wid & 3, fr = lane & 15, fq = lane >> 4;
    int Kop = g.K; asm volatile("" : "+s"(Kop));
    const int K = Kop, nt = K / BK;
    unsigned voffA[2], voffB[2];
#pragma unroll
    for (int i = 0; i < 2; ++i) { int R, C; stage_rc(tid * 16 + i * 8192, R, C); const int Rb = Epi::PERM ? ((R & ~31) + perm32(R & 31)) : R;
        voffA[i] = (unsigned)(R * g.lda + C) * 2u; voffB[i] = (unsigned)(Rb * g.ldb + C) * 2u; }
    const size_t kstep = (size_t)(BK * 2);
    const size_t hstepA = (size_t)HALF * g.lda * 2, hstepB = (size_t)HALF * g.ldb * 2;
    const size_t tstepA = 2 * hstepA, tstepB = 2 * hstepB;
    const unsigned ldsw = (unsigned)wid * 1024u;
    const int aoff = lds_byte(wr * 64 + fr, fq * 8), boff = lds_byte(wc * 32 + fr, fq * 8);
#define PG8_SA(b, h) (((b) * 2 + (h)) * HTB)
#define PG8_SB(b, h) ((4 + (b) * 2 + (h)) * HTB)
#define PG8_STAGE(bufoff, gbase, voff) do { _Pragma("unroll") for (int _i = 0; _i < 2; ++_i) \
        __builtin_amdgcn_global_load_lds((const unsigned*)((const char*)(gbase) + (voff)[_i]), (PG8_LAS unsigned*)(lds + (bufoff) + ldsw + _i * 8192), 16, 0, 0); } while (0)
#define PG8_LDA(dst, b, h) do { _Pragma("unroll") for (int m = 0; m < 4; ++m) _Pragma("unroll") for (int k = 0; k < 2; ++k) dst[m][k] = *(const PG8_LAS bf16x8*)(lds + PG8_SA(b, h) + aoff + m * 2048 + k * 1024); } while (0)
#define PG8_LDB(dst, b, h) do { _Pragma("unroll") for (int n = 0; n < 2; ++n) _Pragma("unroll") for (int k = 0; k < 2; ++k) dst[n][k] = *(const PG8_LAS bf16x8*)(lds + PG8_SB(b, h) + boff + n * 2048 + k * 1024); } while (0)
#define PG8_MMA(ai, bj, At, Bt) do { __builtin_amdgcn_s_setprio(1); _Pragma("unroll") for (int m = 0; m < 4; ++m) _Pragma("unroll") for (int n = 0; n < 2; ++n) _Pragma("unroll") for (int k = 0; k < 2; ++k) \
        acc[ai][bj][m][n] = __builtin_amdgcn_mfma_f32_16x16x32_bf16(Bt[n][k], At[m][k], acc[ai][bj][m][n], 0, 0, 0); __builtin_amdgcn_s_setprio(0); } while (0)
#define PG8_WAIT_V(n) asm volatile("s_waitcnt vmcnt(" #n ")" ::: "memory")
#define PG8_WAIT_L(n) asm volatile("s_waitcnt lgkmcnt(" #n ")" ::: "memory")
#define PG8_BAR __builtin_amdgcn_s_barrier()
#define PG8_SCHED __builtin_amdgcn_sched_barrier(0)
    Unit cur, nxt; int ui = 0;
    if (!S.next(0, cur)) return;
    f32x4 acc[2][2][4][2];
#pragma unroll
    for (int a = 0; a < 2; ++a)
#pragma unroll
        for (int b = 0; b < 2; ++b)
#pragma unroll
            for (int m = 0; m < 4; ++m)
#pragma unroll
                for (int n = 0; n < 2; ++n) acc[a][b][m][n] = (f32x4){0.f, 0.f, 0.f, 0.f};
    bf16x8 At[4][2], B0[2][2], B1[2][2];
    const char* cA = (const char*)g.A + (size_t)cur.pm * tstepA; const char* cB = (const char*)g.Bt + (size_t)cur.pn * tstepB;
    S.a_ready(cur);
    if constexpr (SP2) {
        PG8_STAGE(PG8_SB(0, 0), cB, voffB); PG8_STAGE(PG8_SB(0, 1), cB + hstepB, voffB); PG8_STAGE(PG8_SA(0, 0), cA, voffA); PG8_STAGE(PG8_SA(0, 1), cA + hstepA, voffA);
        if (wr == 1) PG8_BAR;
        PG8_WAIT_V(2); PG8_BAR;
        PG8_STAGE(PG8_SB(1, 0), cB + kstep, voffB); PG8_STAGE(PG8_SA(1, 0), cA + kstep, voffA); PG8_STAGE(PG8_SB(1, 1), cB + hstepB + kstep, voffB);
        PG8_WAIT_V(6); PG8_BAR;
    } else {
        PG8_STAGE(PG8_SB(0, 0), cB, voffB); PG8_STAGE(PG8_SA(0, 0), cA, voffA); PG8_STAGE(PG8_SB(0, 1), cB + hstepB, voffB); PG8_STAGE(PG8_SA(0, 1), cA + hstepA, voffA);
        if (wr == 1) PG8_BAR;
        PG8_WAIT_V(4); PG8_BAR;
        PG8_STAGE(PG8_SB(1, 0), cB + kstep, voffB); PG8_STAGE(PG8_SA(1, 0), cA + kstep, voffA); PG8_STAGE(PG8_SB(1, 1), cB + hstepB + kstep, voffB);
        PG8_WAIT_V(6); PG8_BAR;
    }
    for (;;) {
        const bool has_next = S.next(ui + 1, nxt);
        const char* nA = has_next ? (const char*)g.A + (size_t)nxt.pm * tstepA : cA; const char* nB = has_next ? (const char*)g.Bt + (size_t)nxt.pn * tstepB : cB;
        for (int t = 0; t < nt; t += 2) {
            const bool last = (t == nt - 2);
            const char* a1 = cA + (size_t)(t + 1) * kstep;
            const char* a2 = last ? nA : cA + (size_t)(t + 2) * kstep; const char* b2 = last ? nB : cB + (size_t)(t + 2) * kstep;
            const char* a3 = a2 + kstep; const char* b3 = b2 + kstep;
            if (last && has_next) S.a_ready(nxt);
            if constexpr (SP2) {
            PG8_LDB(B0, 0, 0); PG8_LDB(B1, 0, 1); PG8_SCHED; PG8_LDA(At, 0, 0); PG8_STAGE(PG8_SA(1, 1), a1 + hstepA, voffA);
            PG8_WAIT_V(8); PG8_WAIT_L(0); PG8_BAR; PG8_MMA(0, 0, At, B0); PG8_MMA(0, 1, At, B1); PG8_BAR; PG8_SCHED;
            PG8_LDA(At, 0, 1); PG8_STAGE(PG8_SB(0, 0), b2, voffB); PG8_STAGE(PG8_SB(0, 1), b2 + hstepB, voffB); PG8_STAGE(PG8_SA(0, 0), a2, voffA);
            PG8_WAIT_V(8); PG8_WAIT_L(0); PG8_BAR; PG8_MMA(1, 0, At, B0); PG8_MMA(1, 1, At, B1); PG8_BAR; PG8_SCHED;
            PG8_LDB(B0, 1, 0); PG8_LDB(B1, 1, 1); PG8_SCHED; PG8_LDA(At, 1, 0); PG8_STAGE(PG8_SA(0, 1), a2 + hstepA, voffA);
            PG8_WAIT_V(8); PG8_WAIT_L(0); PG8_BAR; PG8_MMA(0, 0, At, B0); PG8_MMA(0, 1, At, B1); PG8_BAR; PG8_SCHED;
            PG8_LDA(At, 1, 1); PG8_STAGE(PG8_SB(1, 0), b3, voffB); PG8_STAGE(PG8_SB(1, 1), b3 + hstepB, voffB); PG8_STAGE(PG8_SA(1, 0), a3, voffA);
            PG8_WAIT_V(8); PG8_WAIT_L(0); PG8_BAR; PG8_MMA(1, 0, At, B0); PG8_MMA(1, 1, At, B1); PG8_BAR; PG8_SCHED;
            } else {
            PG8_LDB(B0, 0, 0); PG8_SCHED; PG8_LDA(At, 0, 0); PG8_STAGE(PG8_SA(1, 1), a1 + hstepA, voffA);
            PG8_WAIT_L(8); PG8_BAR; PG8_WAIT_L(0); PG8_MMA(0, 0, At, B0); PG8_BAR; PG8_SCHED;
            PG8_LDB(B1, 0, 1); PG8_STAGE(PG8_SB(0, 0), b2, voffB);
            PG8_BAR; PG8_WAIT_L(0); PG8_MMA(0, 1, At, B1); PG8_BAR;
            PG8_LDA(At, 0, 1); PG8_STAGE(PG8_SA(0, 0), a2, voffA);
            PG8_BAR; PG8_WAIT_L(0); PG8_MMA(1, 0, At, B0); PG8_BAR; PG8_SCHED;
            PG8_STAGE(PG8_SB(0, 1), b2 + hstepB, voffB);
            PG8_WAIT_V(6); PG8_BAR; PG8_MMA(1, 1, At, B1); PG8_BAR;
            PG8_LDB(B0, 1, 0); PG8_SCHED; PG8_LDA(At, 1, 0); PG8_STAGE(PG8_SA(0, 1), a2 + hstepA, voffA);
            PG8_WAIT_L(8); PG8_BAR; PG8_WAIT_L(0); PG8_MMA(0, 0, At, B0); PG8_BAR; PG8_SCHED;
            PG8_LDB(B1, 1, 1); PG8_STAGE(PG8_SB(1, 0), b3, voffB);
            PG8_BAR; PG8_WAIT_L(0); PG8_MMA(0, 1, At, B1); PG8_BAR;
            PG8_LDA(At, 1, 1); PG8_STAGE(PG8_SA(1, 0), a3, voffA);
            PG8_BAR; PG8_WAIT_L(0); PG8_MMA(1, 0, At, B0); PG8_BAR; PG8_SCHED;
            PG8_STAGE(PG8_SB(1, 1), b3 + hstepB, voffB);
            PG8_WAIT_V(6); PG8_BAR; PG8_MMA(1, 1, At, B1); PG8_BAR;
            }
        }
        if constexpr (ALIGN_EPI) { if (wr == 0) PG8_BAR; }
        if constexpr (!Epi::AFTER_DRAIN) { E(acc, cur, wr, wc, fr, fq); S.done(cur); }
        if (!has_next) break;
#pragma unroll
        for (int a = 0; a < 2; ++a)
#pragma unroll
            for (int b = 0; b < 2; ++b)
#pragma unroll
                for (int m = 0; m < 4; ++m)
#pragma unroll
                    for (int n = 0; n < 2; ++n) acc[a][b][m][n] = (f32x4){0.f, 0.f, 0.f, 0.f};
        cur = nxt; cA = nA; cB = nB; ++ui;
        if constexpr (ALIGN_EPI) { if (wr == 1) PG8_BAR; }
    }
    PG8_WAIT_V(0);
    if constexpr (!ALIGN_EPI) { if (wr == 0) PG8_BAR; }
    PG8_BAR;
    if constexpr (Epi::AFTER_DRAIN) { E.fused(acc, cur, wr, wc, fr, fq, lds, wid, lane); S.done(cur); }
#undef PG8_SA
#undef PG8_SB
#undef PG8_STAGE
#undef PG8_LDA
#undef PG8_LDB
#undef PG8_MMA
#undef PG8_WAIT_V
#undef PG8_WAIT_L
#undef PG8_BAR
#undef PG8_SCHED
}
}

constexpr int NWAVES = 8;
constexpr int BATCH = 4, SEQ = 2048, DM = 2048, DEPTH = 4, MTOK = BATCH * SEQ;
constexpr int DR = 1024, DN = 1024, NKV = 256, DFF = 8192;
constexpr int RWKV_COLS = 3520, NSA_COLS = 2608, IN_COLS = 6128, NINP = 6144;
constexpr float LN_EPS = 1e-5f, GN_EPS = 64e-5f;
constexpr float DN_ALPHA = 1.681792830507429f;
constexpr float NEGBIG = -1e30f;
constexpr int N_PHASES = 2 + 13 * DEPTH;

constexpr size_t KiB = 1024, MiB = 1u << 20;
constexpr size_t WS_CTL = 0, CTL_ZERO_BYTES = 1 * MiB;
constexpr int CW_BAR = 4096;
constexpr size_t WS_MOD = 1 * MiB;
constexpr size_t WS_ROPE = WS_MOD + 786432;
constexpr size_t WS_B1 = WS_ROPE + 524288;
constexpr size_t WS_WT = 3 * MiB;
constexpr size_t WL_IN = 0, WL_OUT = WL_IN + (size_t)NINP * DM * 2, WL_W1 = WL_OUT + (size_t)DM * DM * 2, WL_W2 = WL_W1 + (size_t)DFF * DM * 2,
                 WL_LORA = WL_W2 + (size_t)DM * DFF * 2, WL_V1 = WL_LORA + (size_t)3072 * 256 * 2, WL_V2 = WL_V1 + (size_t)256 * 1024 * 2,
                 WL_C1 = WL_V2 + (size_t)1024 * 256 * 2, WL_C2 = WL_C1 + (size_t)512 * 2048 * 2, WL_STRIDE = WL_C2 + (size_t)512 * 256 * 2;
constexpr size_t ACT_F32 = (size_t)MTOK * DM * 4;
constexpr size_t R1024_F32 = (size_t)MTOK * 1024 * 4;
constexpr size_t WS_XA = WS_WT + 4 * WL_STRIDE + 1 * MiB;
constexpr size_t WS_XB = WS_XA + ACT_F32, WS_Z = WS_XB + ACT_F32, WS_H = WS_Z + ACT_F32;
constexpr size_t WS_U = WS_H + (size_t)MTOK * DM * 2;
constexpr size_t WS_LA = WS_U + (size_t)MTOK * NINP * 4;
constexpr size_t WS_VB = WS_LA + (size_t)3 * MTOK * 256 * 2;
constexpr size_t WS_V1O = WS_VB + (size_t)MTOK * 1024 * 2;
constexpr size_t WS_VF = WS_V1O + (size_t)MTOK * 256 * 2;
constexpr size_t WS_V = WS_VF + R1024_F32, WS_WD = WS_V + R1024_F32, WS_AA = WS_WD + R1024_F32, WS_GG = WS_AA + R1024_F32, WS_RR = WS_GG + R1024_F32,
                 WS_KK = WS_RR + R1024_F32, WS_KM = WS_KK + R1024_F32, WS_BV = WS_KM + R1024_F32, WS_OS = WS_BV + R1024_F32,
                 WS_OCMP = WS_OS + R1024_F32, WS_OSLC = WS_OCMP + R1024_F32, WS_OWIN = WS_OSLC + R1024_F32, WS_BONUS = WS_OWIN + R1024_F32;
constexpr size_t WS_QN = WS_BONUS + (size_t)MTOK * 16 * 4;
constexpr size_t WS_KCH = WS_QN + (size_t)MTOK * 1024 * 2;
constexpr size_t WS_VCH = WS_KCH + (size_t)16 * 2048 * 64 * 2;
constexpr size_t WS_KS = WS_VCH + (size_t)16 * 2048 * 64 * 2 + 4096;
constexpr size_t WS_KW = WS_KS + (size_t)16 * 2048 * 64 * 2, WS_VST = WS_KW + (size_t)16 * 2048 * 64 * 2, WS_VWT = WS_VST + (size_t)16 * 2048 * 64 * 2;
constexpr size_t WS_GATE = WS_VWT + (size_t)16 * 2048 * 64 * 2;
constexpr size_t WS_CH = WS_GATE + (size_t)MTOK * 48 * 4;
constexpr size_t WS_KC = WS_CH + (size_t)4096 * 256 * 2;
constexpr size_t WS_VCT = WS_KC + (size_t)16 * 128 * 64 * 2;
constexpr size_t WS_MIX = WS_VCT + (size_t)16 * 64 * 128 * 2;
constexpr size_t WS_END = WS_MIX + (size_t)MTOK * DM * 2;
static_assert((size_t)MTOK * DFF * 2 <= (size_t)MTOK * NINP * 4, "HID overlays U");
static_assert(WS_END < (size_t)1560 * MiB, "workspace map too large");

constexpr int RING_BYTES = 131072;
constexpr int LDSCTL_OFF = RING_BYTES, MISC_OFF = LDSCTL_OFF + 320;
constexpr int LDS_BYTES = 147456;

#define GAS __attribute__((address_space(1)))
#define LAS __attribute__((address_space(3)))
typedef unsigned short bf16;
typedef unsigned v4u __attribute__((ext_vector_type(4)));
typedef unsigned v2u __attribute__((ext_vector_type(2)));
typedef float f32x4 __attribute__((ext_vector_type(4)));
typedef float f32x2 __attribute__((ext_vector_type(2)));
typedef short bf16x8 __attribute__((ext_vector_type(8)));
typedef short bf16x4 __attribute__((ext_vector_type(4)));
typedef GAS unsigned gu32;
#define RLX_AGENT __ATOMIC_RELAXED, __HIP_MEMORY_SCOPE_AGENT
#define LDS_WAIT() asm volatile("s_waitcnt lgkmcnt(0)" ::: "memory")
#define VM_WAIT() asm volatile("s_waitcnt vmcnt(0)" ::: "memory")
__device__ __forceinline__ int fresh_lane_id() { unsigned z = 0u; asm volatile("" : "+v"(z)); return (int)__builtin_amdgcn_mbcnt_hi(~0u, __builtin_amdgcn_mbcnt_lo(~0u, z)); }
__device__ __forceinline__ unsigned pk2(float lo, float hi) { return pg8::cvt_pk_bf16(lo, hi); }
__device__ __forceinline__ float bf2f(unsigned short b) { return __uint_as_float((unsigned)b << 16); }
__device__ __forceinline__ float sigmoidf_(float x) { return 1.0f / (1.0f + __expf(-x)); }
__device__ __forceinline__ float wave_sum(float v) {
#pragma unroll
    for (int o = 1; o < 64; o <<= 1) v += __shfl_xor(v, o);
    return v;
}
template <int CTRL> __device__ __forceinline__ float dppf(float x) { return __int_as_float(__builtin_amdgcn_mov_dpp(__float_as_int(x), CTRL, 0xF, 0xF, true)); }
__device__ __forceinline__ float row16_sum(float x) { x += dppf<0xB1>(x); x += dppf<0x4E>(x); x += dppf<0x141>(x); x += dppf<0x140>(x); return x; }
__device__ __forceinline__ float quad_sum(float x) { x += dppf<0xB1>(x); x += dppf<0x4E>(x); return x; }

#define XB_TMO      128
#define XB_XCNT(j)  (256  + 64 * (j))
#define XB_XSUB(j)  (1280 + 64 * (j))
#define XB_XGEN(j)  (2304 + 64 * (j))
#define XB_TOP      3328
#define XB_TOPGEN   3392
#define XCD_BAR_WORDS 3456
#define XB_SPIN_CAP (1u << 18)

__device__ __forceinline__ unsigned xb_ld(unsigned* p)              { return __hip_atomic_load(p, __ATOMIC_RELAXED, __HIP_MEMORY_SCOPE_AGENT); }
__device__ __forceinline__ unsigned xb_add(unsigned* p, unsigned v) { return __hip_atomic_fetch_add(p, v, __ATOMIC_RELAXED, __HIP_MEMORY_SCOPE_AGENT); }
__device__ __forceinline__ unsigned xb_xcc_id() { return (unsigned)__builtin_amdgcn_s_getreg((3 << 11) | 20) & 0xFu; }
#define XB_SPIN(cond, bar) do { unsigned _sp = 0; while (cond) { __builtin_amdgcn_s_sleep(1); \
    if ((++_sp & 255u) == 0u) { if (xb_ld(&(bar)[XB_TMO])) break; if (_sp > XB_SPIN_CAP) { atomicAdd(&(bar)[XB_TMO], 1u); break; } } } } while (0)

struct XcdBarrier {
    unsigned* bar; unsigned x;
    volatile LAS unsigned* st;
};

__device__ __forceinline__ bool xb_thread0(int wave_id) { return wave_id == 0 && fresh_lane_id() == 0; }
__device__ __forceinline__ XcdBarrier xcd_barrier_post(unsigned* bar, volatile LAS unsigned* st, int wave_id) {
    XcdBarrier b; b.bar = bar; b.x = xb_xcc_id(); b.st = st;
    if (xb_thread0(wave_id)) (void)xb_add(&bar[XB_XCNT(b.x)], 1u);
    return b;
}
__device__ __forceinline__ void xcd_barrier_complete(unsigned* bar, unsigned x, unsigned& nloc, unsigned& nx) {
    const unsigned G = gridDim.x * gridDim.y * gridDim.z;
    unsigned sum, cnt, mine, sp = 0u;
    for (;;) {
        sum = 0u; cnt = 0u; mine = 0u;
#pragma unroll
        for (unsigned j = 0; j < 16; ++j) { const unsigned c = xb_ld(&bar[XB_XCNT(j)]); sum += c; cnt += (c > 0u) ? 1u : 0u; mine = (j == x) ? c : mine; }
        if (sum == G) break;
        __builtin_amdgcn_s_sleep(1);
        if ((++sp & 255u) == 0u) { if (xb_ld(&bar[XB_TMO])) break; if (sp > XB_SPIN_CAP) { atomicAdd(&bar[XB_TMO], 1u); break; } }
    }
    nloc = mine > 0u ? mine : 1u; nx = cnt > 0u ? cnt : 1u;
}

__device__ __forceinline__ void xcd_barrier(const XcdBarrier& b, int wave_id) {
    asm volatile("s_waitcnt vmcnt(0)" ::: "memory");
    __syncthreads();
    if (xb_thread0(wave_id)) {
        unsigned* bar = b.bar;
        __builtin_amdgcn_s_waitcnt(0);
        unsigned nloc = b.st[0], nx = b.st[1];
        if (nloc == 0u) { xcd_barrier_complete(bar, b.x, nloc, nx); b.st[0] = nloc; b.st[1] = nx; }
        const unsigned old = xb_add(&bar[XB_XSUB(b.x)], 1u);
        const unsigned gen = old / nloc;
        if (old + 1u == (gen + 1u) * nloc) {
            __builtin_amdgcn_fence(__ATOMIC_RELEASE, "agent");
            asm volatile("s_waitcnt vmcnt(0)" ::: "memory");
            const unsigned og = xb_add(&bar[XB_TOP], 1u);
            const unsigned tg = og / nx;
            if (og + 1u == (tg + 1u) * nx) xb_add(&bar[XB_TOPGEN], 1u);
            else XB_SPIN(xb_ld(&bar[XB_TOPGEN]) == tg, bar);
            __builtin_amdgcn_fence(__ATOMIC_ACQUIRE, "agent");
            xb_add(&bar[XB_XGEN(b.x)], 1u);
            asm volatile("s_waitcnt vmcnt(0)" ::: "memory");
        } else {
            XB_SPIN(xb_ld(&bar[XB_XGEN(b.x)]) == gen, bar);
            __builtin_amdgcn_fence(__ATOMIC_ACQUIRE, "agent");
            asm volatile("s_waitcnt vmcnt(0)" ::: "memory");
        }
    }
    __syncthreads();
}

struct Args { const float* in[29]; float* out; unsigned char* ws; int ph_lo, ph_hi; };
typedef const __attribute__((address_space(4))) Args* ArgP;
#define INP(a, i) ((const float*)(const GAS float*)((a)->in[(i)]))
struct Frame {
    LAS unsigned char* lds;
    volatile LAS unsigned* MISC;
    gu32* ctl;
    int tid, lane, wave, vcu, G;
    GAS unsigned char* ws;
};
__device__ __forceinline__ const float* modp(const Frame& F, int l, int b, int which) { return (const float*)(F.ws + WS_MOD) + ((size_t)(l * 4 + b) * 12288 + which * 2048); }
__device__ __forceinline__ GAS unsigned char* wlayer(const Frame& F, int l) { return F.ws + WS_WT + (size_t)l * WL_STRIDE; }

struct CDesc { const float* src; bf16* dst; int ldw, Kv, Nv, Kp, Np; };
__device__ __forceinline__ bool conv_desc(ArgP a, const Frame& F, int l, int kind, CDesc& d) {
    GAS unsigned char* wl = wlayer(F, l);
    switch (kind) {
    case 0: d.src = INP(a, 4) + (size_t)l * 2048 * 6128; d.dst = (bf16*)(wl + WL_IN); d.ldw = 6128; d.Kv = 2048; d.Nv = 6128; d.Kp = 2048; d.Np = 6144; return true;
    case 1: d.src = INP(a, 22) + (size_t)l * 2048 * 2048; d.dst = (bf16*)(wl + WL_OUT); d.ldw = 2048; d.Kv = 2048; d.Nv = 2048; d.Kp = 2048; d.Np = 2048; return true;
    case 2: d.src = INP(a, 25) + (size_t)l * 2048 * 8192; d.dst = (bf16*)(wl + WL_W1); d.ldw = 8192; d.Kv = 2048; d.Nv = 8192; d.Kp = 2048; d.Np = 8192; return true;
    case 3: d.src = INP(a, 26) + (size_t)l * 8192 * 2048; d.dst = (bf16*)(wl + WL_W2); d.ldw = 2048; d.Kv = 8192; d.Nv = 2048; d.Kp = 8192; d.Np = 2048; return true;
    case 4: d.src = INP(a, 7) + (size_t)l * 96 * 1024; d.dst = (bf16*)(wl + WL_LORA); d.ldw = 1024; d.Kv = 96; d.Nv = 1024; d.Kp = 256; d.Np = 1024; return true;
    case 5: d.src = INP(a, 9) + (size_t)l * 96 * 1024; d.dst = (bf16*)(wl + WL_LORA) + (size_t)1024 * 256; d.ldw = 1024; d.Kv = 96; d.Nv = 1024; d.Kp = 256; d.Np = 1024; return true;
    case 6: d.src = INP(a, 10) + (size_t)l * 256 * 1024; d.dst = (bf16*)(wl + WL_LORA) + (size_t)2048 * 256; d.ldw = 1024; d.Kv = 256; d.Nv = 1024; d.Kp = 256; d.Np = 1024; return true;
    case 7: if (l == 0) return false; d.src = INP(a, 17) + (size_t)(l - 1) * 1024 * 64; d.dst = (bf16*)(wl + WL_V1); d.ldw = 64; d.Kv = 1024; d.Nv = 64; d.Kp = 1024; d.Np = 256; return true;
    case 8: if (l == 0) return false; d.src = INP(a, 18) + (size_t)(l - 1) * 64 * 1024; d.dst = (bf16*)(wl + WL_V2); d.ldw = 1024; d.Kv = 64; d.Nv = 1024; d.Kp = 256; d.Np = 1024; return true;
    case 9: d.src = INP(a, 20) + (size_t)(l * 2) * 2048 * 256; d.dst = (bf16*)(wl + WL_C1); d.ldw = 256; d.Kv = 2048; d.Nv = 256; d.Kp = 2048; d.Np = 256; return true;
    case 10: d.src = INP(a, 20) + (size_t)(l * 2 + 1) * 2048 * 256; d.dst = (bf16*)(wl + WL_C1) + (size_t)256 * 2048; d.ldw = 256; d.Kv = 2048; d.Nv = 256; d.Kp = 2048; d.Np = 256; return true;
    case 11: d.src = INP(a, 21) + (size_t)(l * 2) * 256 * 64; d.dst = (bf16*)(wl + WL_C2); d.ldw = 64; d.Kv = 256; d.Nv = 64; d.Kp = 256; d.Np = 256; return true;
    default: d.src = INP(a, 21) + (size_t)(l * 2 + 1) * 256 * 64; d.dst = (bf16*)(wl + WL_C2) + (size_t)256 * 256; d.ldw = 64; d.Kv = 256; d.Nv = 64; d.Kp = 256; d.Np = 256; return true;
    }
}
__device__ __forceinline__ void transpose_load(const CDesc& d, int item, int lane, f32x4 (&v)[8]) {
    const int nblk = d.Np / 32, kb = item / nblk, nb = item % nblk, k0 = 64 * kb, n0 = 32 * nb;
    const int n4 = lane & 7, n = n0 + 4 * n4; const bool nok = n < d.Nv;
#pragma unroll
    for (int i = 0; i < 8; ++i) { const int k = k0 + 8 * i + (lane >> 3); v[i] = (f32x4){0.f, 0.f, 0.f, 0.f}; if (nok && k < d.Kv) v[i] = *(const f32x4*)(d.src + (size_t)k * d.ldw + n); }
}
__device__ __forceinline__ void transpose_finish(const CDesc& d, LAS float* scr, int item, int lane, const f32x4 (&v)[8]) {
    const int nblk = d.Np / 32, kb = item / nblk, nb = item % nblk, k0 = 64 * kb, n0 = 32 * nb; const int n4 = lane & 7;
#pragma unroll
    for (int i = 0; i < 8; ++i) { LAS float* p = scr + (8 * i + (lane >> 3)) * 33 + 4 * n4; p[0] = v[i].x; p[1] = v[i].y; p[2] = v[i].z; p[3] = v[i].w; }
    LDS_WAIT(); asm volatile("" ::: "memory");
    const int c = lane & 7;
#pragma unroll
    for (int j = 0; j < 4; ++j) { const int nn = (lane >> 3) + 8 * j; const LAS float* s = scr + (8 * c) * 33 + nn;
        v4u o; o.x = pk2(s[0 * 33], s[1 * 33]); o.y = pk2(s[2 * 33], s[3 * 33]); o.z = pk2(s[4 * 33], s[5 * 33]); o.w = pk2(s[6 * 33], s[7 * 33]);
        *(GAS v4u*)(d.dst + (size_t)(n0 + nn) * d.Kp + k0 + 8 * c) = o; }
    LDS_WAIT(); asm volatile("" ::: "memory");
}
__device__ __forceinline__ void rope_entry(int idx, f32x2* tab) {
    const int t = idx >> 5, i = idx & 31;
    double p = 1.0; for (int n = 0; n < i; ++n) p *= 0.7498942093324559;
    const float invf = (float)p; const float angf = (float)t * invf;
    const double x = (double)angf; const double kd = __builtin_rint(x * 0.6366197723675814); const int q = (int)kd;
    double r = __builtin_fma(-kd, 1.5707963267948966, x); r = __builtin_fma(-kd, 6.123233995736766e-17, r);
    const double r2 = r * r;
    const double s = r * (1.0 + r2 * (-1.0 / 6.0 + r2 * (1.0 / 120.0 + r2 * (-1.0 / 5040.0 + r2 * (1.0 / 362880.0 + r2 * (-1.0 / 39916800.0 + r2 * (1.0 / 6227020800.0 + r2 * (-1.0 / 1307674368000.0))))))));
    const double c = 1.0 + r2 * (-0.5 + r2 * (1.0 / 24.0 + r2 * (-1.0 / 720.0 + r2 * (1.0 / 40320.0 + r2 * (-1.0 / 3628800.0 + r2 * (1.0 / 479001600.0 + r2 * (-1.0 / 87178291200.0 + r2 * (1.0 / 20922789888000.0))))))));
    double cs, sn; const int qq = q & 3;
    if (qq == 0) { cs = c; sn = s; } else if (qq == 1) { cs = -s; sn = c; } else if (qq == 2) { cs = -c; sn = -s; } else { cs = s; sn = -c; }
    tab[idx] = (f32x2){(float)cs, (float)sn};
}
__device__ __forceinline__ void phase_pre0(Frame& F, ArgP a) {
    LAS float* condT = (LAS float*)(F.lds);
    LAS float* part = (LAS float*)(F.lds + 32768);
    LAS float* pv = (LAS float*)(F.lds + 40960);
    { const float* c = INP(a, 1);
      for (int i = F.tid; i < 8192; i += 512) { const int k = i >> 2, b = i & 3; const float x = c[b * 2048 + k]; condT[i] = x / (1.f + __expf(-x)); }
      __syncthreads();
      float* mod = (float*)(F.ws + WS_MOD);
      _Pragma("nounroll") for (int rep_ = 0; rep_ < 1 + ((MK_REPEAT >> 15) & 1); ++rep_)
      for (int it = blockIdx.x; it < 768; it += F.G) {
          const int l = it / 192, n0 = (it % 192) * 64;
          const float* W = INP(a, 2) + (size_t)l * 2048 * 12288 + n0 + F.lane;
          float a0 = 0.f, a1 = 0.f, a2 = 0.f, a3 = 0.f; const int k0 = F.wave * 256;
#pragma unroll 16
          for (int kk = 0; kk < 256; ++kk) { const int k = k0 + kk; const float wv = W[(size_t)k * 12288]; const f32x4 cv = *(const LAS f32x4*)(condT + 4 * k);
              a0 += cv.x * wv; a1 += cv.y * wv; a2 += cv.z * wv; a3 += cv.w * wv; }
          part[(F.wave * 4 + 0) * 64 + F.lane] = a0; part[(F.wave * 4 + 1) * 64 + F.lane] = a1; part[(F.wave * 4 + 2) * 64 + F.lane] = a2; part[(F.wave * 4 + 3) * 64 + F.lane] = a3;
          __syncthreads();
          if (F.tid < 256) { const int b = F.tid >> 6, n = F.tid & 63; float s = 0.f;
#pragma unroll
              for (int w = 0; w < 8; ++w) s += part[(w * 4 + b) * 64 + n];
              mod[(size_t)(l * 4 + b) * 12288 + n0 + n] = s + INP(a, 3)[l * 12288 + n0 + n]; }
          __syncthreads();
      } }
    { float* B1 = (float*)(F.ws + WS_B1);
      for (int it = (int)blockIdx.x - 64; it < 32; it += F.G) {
          if (it < 0) continue;
          const int l = it >> 3, j = (it >> 2) & 1, cg = it & 3;
          const float* pos = INP(a, 19) + (size_t)(l * 2 + j) * 2048;
          for (int i = F.tid; i < 2048; i += 512) pv[i] = pos[i];
          __syncthreads();
          const float* W = INP(a, 20) + (size_t)(l * 2 + j) * 2048 * 256 + cg * 64 + F.lane;
          float acc = 0.f; const int k0 = F.wave * 256;
#pragma unroll 8
          for (int kk = 0; kk < 256; ++kk) acc += pv[k0 + kk] * W[(size_t)(k0 + kk) * 256];
          part[F.wave * 64 + F.lane] = acc;
          __syncthreads();
          if (F.tid < 64) { float s = 0.f;
#pragma unroll
              for (int w = 0; w < 8; ++w) s += part[w * 64 + F.tid];
              B1[(l * 2 + j) * 256 + cg * 64 + F.tid] = s; }
          __syncthreads();
      } }
    { f32x2* tab = (f32x2*)(F.ws + WS_ROPE);
      for (int idx = blockIdx.x * 512 + F.tid; idx < 2048 * 32; idx += F.G * 512) rope_entry(idx, tab); }
    { __syncthreads();
      LAS float* scr = (LAS float*)(F.lds + F.wave * 16384);
      const int gw = F.vcu * NWAVES + F.wave, NGW = F.G * NWAVES; int off = 0;
      _Pragma("nounroll") for (int rep_ = 0; rep_ < 1 + ((MK_REPEAT >> 16) & 1); ++rep_)
      for (int l = 0; l < DEPTH; ++l)
          for (int kind = 0; kind < 13; ++kind) {
              CDesc d; if (!conv_desc(a, F, l, kind, d)) continue;
              const int nitems = (d.Kp / 64) * (d.Np / 32);
              int start = gw - (off % NGW); if (start < 0) start += NGW;
              { f32x4 va[8], vb[8]; int it = start; if (it < nitems) transpose_load(d, it, F.lane, va);
                while (it < nitems) { const int nx = it + NGW; if (nx < nitems) transpose_load(d, nx, F.lane, vb);
                    transpose_finish(d, scr, it, F.lane, va);
#pragma unroll
                    for (int i = 0; i < 8; ++i) va[i] = vb[i];
                    it = nx; } }
              off += nitems;
          }
      __syncthreads(); }
}
__device__ __forceinline__ void phase_pre1(Frame& F, ArgP a) {
    const int gw = F.vcu * NWAVES + F.wave, NGW = F.G * NWAVES;
    bf16* H = (bf16*)(F.ws + WS_H);
    for (int m = gw; m < MTOK; m += NGW) {
        const int b = m >> 11; const float* xr = INP(a, 0) + (size_t)m * DM; const float* sh = modp(F, 0, b, 0); const float* sc = modp(F, 0, b, 1);
#pragma unroll
        for (int j = 0; j < 8; ++j) { const int col = 4 * (F.lane + 64 * j);
            const f32x4 xv = *(const f32x4*)(xr + col), s4 = *(const f32x4*)(sc + col), h4 = *(const f32x4*)(sh + col);
            const f32x4 h = xv * (s4 + 1.0f) + h4; v2u o; o.x = pk2(h.x, h.y); o.y = pk2(h.z, h.w);
            *(v2u*)(H + (size_t)m * DM + col) = o; }
    }
}
__device__ __forceinline__ void phase_prep(Frame& F, ArgP a, int l) {
    LAS bf16* stT = (LAS bf16*)(F.lds);
    const float* U = (const float*)(F.ws + WS_U); const float* mu = INP(a, 5) + (size_t)l * RWKV_COLS;
    const f32x2* rope = (const f32x2*)(F.ws + WS_ROPE);
    bf16* LA = (bf16*)(F.ws + WS_LA); float* V0 = (float*)(F.ws + (l == 0 ? WS_VF : WS_V)); bf16* VB = (bf16*)(F.ws + WS_VB);
    bf16* QN = (bf16*)(F.ws + WS_QN); bf16* KCH = (bf16*)(F.ws + WS_KCH); bf16* VCH = (bf16*)(F.ws + WS_VCH); bf16* KS = (bf16*)(F.ws + WS_KS); bf16* KW = (bf16*)(F.ws + WS_KW);
    bf16* VST = (bf16*)(F.ws + WS_VST); bf16* VWT = (bf16*)(F.ws + WS_VWT); float* GATE = (float*)(F.ws + WS_GATE);
    const int lane = F.lane;
    unsigned zz_ = 0u; asm volatile("" : "+v"(zz_)); const v4u zero4 = (v4u){zz_, zz_, zz_, zz_};
    if (blockIdx.x == 0 && F.tid < 256) *(v4u*)(F.ws + WS_VCH + (size_t)16 * 2048 * 64 * 2 + F.tid * 16) = zero4;
    for (int item = blockIdx.x; item < MTOK / 32; item += F.G) {
        const int m0 = item * 32, b = m0 >> 11, tbase = m0 & 2047;
        for (int tl4 = 0; tl4 < 4; ++tl4) {
            const int tl = F.wave * 4 + tl4, m = m0 + tl, t = tbase + tl;
            const float* ur = U + (size_t)m * NINP; const bool hasprev = t > 0;
            for (int s = 8; s < 24; ++s) {
                const int col = s * 256 + 4 * lane;
                f32x4 v = *(const f32x4*)(ur + col);
                if (col < RWKV_COLS) { f32x4 pvv = (f32x4){0.f, 0.f, 0.f, 0.f}; if (hasprev) pvv = *(const f32x4*)(ur - NINP + col);
                    const f32x4 m4 = *(const f32x4*)(mu + col); v = v + (pvv - v) * m4; }
                f32x4 o = v;
                if (s >= 13) {
                    f32x4 pr; pr.x = __shfl_xor(v.x, 8); pr.y = __shfl_xor(v.y, 8); pr.z = __shfl_xor(v.z, 8); pr.w = __shfl_xor(v.w, 8);
                    const int d = col & 63, i0 = d & 31;
                    const f32x4 cs01 = *(const f32x4*)(rope + t * 32 + i0), cs23 = *(const f32x4*)(rope + t * 32 + i0 + 2);
                    const f32x4 cs = (f32x4){cs01.x, cs01.z, cs23.x, cs23.z}, sn = (f32x4){cs01.y, cs01.w, cs23.y, cs23.w};
                    o = (d < 32) ? (v * cs - pr * sn) : (v * cs + pr * sn);
                }
                if (col < 2048 + 1024) {
                    const int c = col - 2048; *(f32x4*)(V0 + (size_t)m * 1024 + c) = v;
                    if (l > 0) { v2u w; w.x = pk2(v.x, v.y); w.y = pk2(v.z, v.w); *(v2u*)(VB + (size_t)m * 1024 + c) = w; }
                } else if (col < 3168) {
                    const int c = col - 3072; v2u w; w.x = pk2(tanhf(v.x), tanhf(v.y)); w.y = pk2(tanhf(v.z), tanhf(v.w)); *(v2u*)(LA + (size_t)m * 256 + c) = w;
                } else if (col < 3264) {
                    const int c = col - 3168; v2u w; w.x = pk2(v.x, v.y); w.y = pk2(v.z, v.w); *(v2u*)(LA + (size_t)(MTOK + m) * 256 + c) = w;
                } else if (col < 3520) {
                    const int c = col - 3264; v2u w; w.x = pk2(sigmoidf_(v.x), sigmoidf_(v.y)); w.y = pk2(sigmoidf_(v.z), sigmoidf_(v.w)); *(v2u*)(LA + (size_t)(2 * MTOK + m) * 256 + c) = w;
                } else {
                    const int ci = col - 3520;
                    if (ci < 1024) { const float qs = 0.18033688011112042f;     v2u w; w.x = pk2(o.x * qs, o.y * qs); w.y = pk2(o.z * qs, o.w * qs); *(v2u*)(QN + (size_t)m * 1024 + ci) = w; }
                    else if (ci < 2560) {
                        const int r = (ci - 1024) >> 8, cc = (ci - 1024) & 255, g = cc >> 6, d = cc & 63;
                        const size_t hm = ((size_t)((b * 4 + g) * 2048 + t)) * 64 + d;
                        if (r == 0) { v2u w; w.x = pk2(o.x, o.y); w.y = pk2(o.z, o.w); *(v2u*)(KCH + hm) = w; }
                        else if (r == 1) { v2u w; w.x = pk2(v.x, v.y); w.y = pk2(v.z, v.w); *(v2u*)(VCH + hm) = w; }
                        else if (r == 2) { v2u w; w.x = pk2(o.x, o.y); w.y = pk2(o.z, o.w); *(v2u*)(KS + hm) = w; }
                        else if (r == 4) { v2u w; w.x = pk2(o.x, o.y); w.y = pk2(o.z, o.w); *(v2u*)(KW + hm) = w; }
                        else { const int which = (r == 3) ? 0 : 1; LAS bf16* sp = stT + (size_t)(which * 256 + cc) * 40 + tl;
                            const unsigned w0 = pk2(v.x, v.y), w1 = pk2(v.z, v.w);
                            sp[0] = (bf16)(w0 & 0xffffu); sp[40] = (bf16)(w0 >> 16); sp[80] = (bf16)(w1 & 0xffffu); sp[120] = (bf16)(w1 >> 16); }
                    } else if (ci < 2608) { const int c = ci - 2560; *(f32x4*)(GATE + (size_t)m * 48 + c) = (f32x4){sigmoidf_(v.x), sigmoidf_(v.y), sigmoidf_(v.z), sigmoidf_(v.w)}; }
                }
            }
            if (lane < 20) *(v4u*)(LA + (size_t)m * 256 + 96 + 8 * lane) = zero4;
            else if (lane >= 32 && lane < 52) *(v4u*)(LA + (size_t)(MTOK + m) * 256 + 96 + 8 * (lane - 32)) = zero4;
        }
        __syncthreads();
#pragma unroll
        for (int i = 0; i < 4; ++i) { const int idx = F.tid + 512 * i, which = idx >> 10, cc = (idx >> 2) & 255, piece = idx & 3, g = cc >> 6, d = cc & 63;
            const v4u val = *(const LAS v4u*)(stT + (size_t)(which * 256 + cc) * 40 + piece * 8);
            bf16* dst = (which ? VWT : VST) + ((size_t)((b * 4 + g) * 64 + d)) * 2048 + tbase + piece * 8;
            *(v4u*)dst = val; }
        __syncthreads();
    }
}
using pg8::Unit;
struct FStoreF32 { float* O; int ldc;
    __device__ __forceinline__ void operator()(const Unit&, int row, int col, f32x4 v) const { *(f32x4*)(O + (size_t)row * ldc + col) = v; } };
struct FLora { float* WD; float* AA; float* GG; const float* w0; const float* a0;
    __device__ __forceinline__ void operator()(const Unit& u, int row, int col, f32x4 v) const {
        const int s = u.pn >> 2, tok = row - s * MTOK, c = col - s * 1024; const size_t o = (size_t)tok * 1024 + c;
        if (s == 0) { const f32x4 b = *(const f32x4*)(w0 + c); f32x4 r;
#pragma unroll
            for (int i = 0; i < 4; ++i) { const float x = b[i] + v[i]; const float sg = 1.0f / (1.0f + __expf(-x)); r[i] = __expf(-0.6065306597126334f * sg); }
            *(f32x4*)(WD + o) = r; }
        else if (s == 1) { const f32x4 b = *(const f32x4*)(a0 + c); f32x4 r;
#pragma unroll
            for (int i = 0; i < 4; ++i) r[i] = 1.0f / (1.0f + __expf(-(b[i] + v[i])));
            *(f32x4*)(AA + o) = r; }
        else *(f32x4*)(GG + o) = v;
    } };
struct FStoreBf8 { bf16* O; int ldc;
    __device__ __forceinline__ void operator()(const Unit&, int row, int col, f32x4 v0, f32x4 v1) const {
        v4u w; w.x = pk2(v0.x, v0.y); w.y = pk2(v0.z, v0.w); w.z = pk2(v1.x, v1.y); w.w = pk2(v1.z, v1.w); *(v4u*)(O + (size_t)row * ldc + col) = w; } };
__device__ __forceinline__ float gelu_tanh(float x) { const float u = 0.7978845608028654f * (x + 0.044715f * x * x * x); return x / (1.0f + __expf(-2.0f * u)); }
struct FCmp1 { bf16* CH; const float* B1;
    __device__ __forceinline__ void operator()(const Unit& u, int row, int col, f32x4 v0, f32x4 v1) const {
        const int j = u.pm >> 3, ci = col - j * 256; const f32x4 b0 = *(const f32x4*)(B1 + j * 256 + ci), b1 = *(const f32x4*)(B1 + j * 256 + ci + 4);
        v0 = v0 + b0; v1 = v1 + b1; v4u w; w.x = pk2(gelu_tanh(v0.x), gelu_tanh(v0.y)); w.y = pk2(gelu_tanh(v0.z), gelu_tanh(v0.w)); w.z = pk2(gelu_tanh(v1.x), gelu_tanh(v1.y)); w.w = pk2(gelu_tanh(v1.z), gelu_tanh(v1.w));
        *(v4u*)(CH + (size_t)row * 256 + ci) = w; } };
struct FV2 { float* V; const float* VF; const float* v0;
    __device__ __forceinline__ void operator()(const Unit&, int row, int col, f32x4 acc) const {
        const size_t o = (size_t)row * 1024 + col; const f32x4 v = *(const f32x4*)(V + o), vf = *(const f32x4*)(VF + o), b = *(const f32x4*)(v0 + col); f32x4 r;
#pragma unroll
        for (int i = 0; i < 4; ++i) { const float s = 1.0f / (1.0f + __expf(-(b[i] + acc[i]))); r[i] = v[i] + (vf[i] - v[i]) * s; }
        *(f32x4*)(V + o) = r; } };
struct FCmp2 { bf16* KC; bf16* VCT;
    __device__ __forceinline__ void operator()(const Unit& u, int row, int col, f32x4 v) const {
        const int j = u.pm >> 3, ci = col - j * 256; if (ci >= 64) return;
        const int rr = row - j * 2048, bg = rr >> 7, c = rr & 127;
        if (j == 0) { v2u w; w.x = pk2(v.x, v.y); w.y = pk2(v.z, v.w); *(v2u*)(KC + (size_t)(bg * 128 + c) * 64 + ci) = w; }
        else { const unsigned w0 = pk2(v.x, v.y), w1 = pk2(v.z, v.w); bf16* p = VCT + (size_t)(bg * 64 + ci) * 128 + c;
            p[0] = (bf16)(w0 & 0xffffu); p[128] = (bf16)(w0 >> 16); p[256] = (bf16)(w1 & 0xffffu); p[384] = (bf16)(w1 >> 16); }
    } };
struct FResid { float* Z; const float* X; const float* gt;
    __device__ __forceinline__ void operator()(const Unit&, int row, int col, f32x4 acc) const {
        const int b = row >> 11; const size_t o = (size_t)row * DM + col; const f32x4 x = *(const f32x4*)(X + o), g = *(const f32x4*)(gt + (size_t)b * 12288 + col);
        *(f32x4*)(Z + o) = x * DN_ALPHA + (g + 1.0f) * acc; } };
struct FRelu2 { bf16* O;
    __device__ __forceinline__ void operator()(const Unit&, int row, int col, f32x4 v0, f32x4 v1) const {
        f32x4 a, b;
#pragma unroll
        for (int i = 0; i < 4; ++i) { const float x = v0[i] > 0.f ? v0[i] : 0.f, y = v1[i] > 0.f ? v1[i] : 0.f; a[i] = x * x; b[i] = y * y; }
        v4u w; w.x = pk2(a.x, a.y); w.y = pk2(a.z, a.w); w.z = pk2(b.x, b.y); w.w = pk2(b.z, b.w); *(v4u*)(O + (size_t)row * DFF + col) = w; } };

constexpr int SC_TC = 32, SC_BUF_FLOATS = 5 * SC_TC * 64 + SC_TC * 16;
__device__ __forceinline__ void phase_scan(Frame& F, ArgP a, int l) {
    const float* U = (const float*)(F.ws + WS_U); const float* mu = INP(a, 5) + (size_t)l * RWKV_COLS;
    const float* WD = (const float*)(F.ws + WS_WD); const float* AA = (const float*)(F.ws + WS_AA); const float* VV = (const float*)(F.ws + (l == 0 ? WS_VF : WS_V));
    const float* k_kp = INP(a, 11) + l * 1024; const float* k_ap = INP(a, 12) + l * 1024; const float* r_kp = INP(a, 13) + l * 1024;
    float* OS = (float*)(F.ws + WS_OS); float* BON = (float*)(F.ws + WS_BONUS);
    LAS float* buf = (LAS float*)F.lds;
    const int lane = F.lane, w = F.wave, rl = lane >> 4, kq = lane & 15, tid2 = F.tid - 256;
    for (int it = F.vcu; it < 256; it += F.G) {
        const int bh = it >> 2, q4 = it & 3, b = bh >> 4, h = bh & 15; const size_t m0 = (size_t)b * 2048; const int col0 = h * 64;
        __syncthreads();
        if (w >= 4) {
            const int f4 = tid2 & 15, cc = col0 + 4 * f4;
            const f32x4 mur = *(const f32x4*)(mu + cc), muk = *(const f32x4*)(mu + 1024 + cc), kkp = *(const f32x4*)(k_kp + cc), kap = *(const f32x4*)(k_ap + cc), rkp = *(const f32x4*)(r_kp + cc);
            f32x4 ru[2], ku[2], rp[2], kp[2], aa[2], wd[2], vld;
#define SC_ISSUE(c) do { const int tc0 = (c) * SC_TC; \
            _Pragma("unroll") for (int i = 0; i < 2; ++i) { const int st = (tid2 >> 4) + 16 * i, t = tc0 + st; const size_t m = m0 + t; const float* ur = U + m * NINP + cc; \
                ru[i] = *(const f32x4*)ur; ku[i] = *(const f32x4*)(ur + 1024); rp[i] = (f32x4){0.f, 0.f, 0.f, 0.f}; kp[i] = rp[i]; \
                if (t > 0) { rp[i] = *(const f32x4*)(ur - NINP); kp[i] = *(const f32x4*)(ur - NINP + 1024); } \
                aa[i] = *(const f32x4*)(AA + m * 1024 + cc); wd[i] = *(const f32x4*)(WD + m * 1024 + cc); } \
            if (tid2 < 128) { const int st = tid2 >> 2, g4_ = tid2 & 3; vld = *(const f32x4*)(VV + (m0 + tc0 + st) * 1024 + col0 + 16 * q4 + 4 * g4_); } } while (0)
#define SC_COMMIT(c) do { LAS float* bb = buf + ((c) % 3) * SC_BUF_FLOATS; const int tc0 = (c) * SC_TC; \
            _Pragma("unroll") for (int i = 0; i < 2; ++i) { const int st = (tid2 >> 4) + 16 * i; const size_t m = m0 + tc0 + st; \
                const f32x4 r4 = ru[i] + (rp[i] - ru[i]) * mur, k4 = ku[i] + (kp[i] - ku[i]) * muk; const f32x4 kr = k4 * kkp; \
                const float ss = row16_sum((kr.x * kr.x + kr.y * kr.y) + (kr.z * kr.z + kr.w * kr.w)); \
                const float inv = 1.0f / fmaxf(sqrtf(ss), 1e-12f); const f32x4 kk = kr * inv; const f32x4 km = k4 * ((aa[i] - 1.0f) * kap + 1.0f); \
                const f32x4 pr = r4 * km * rkp; const float bon = row16_sum((pr.x + pr.y) + (pr.z + pr.w)); \
                if (q4 == 0 && f4 == 0) BON[m * 16 + h] = bon; \
                *(LAS f32x4*)(bb + (0 * SC_TC + st) * 64 + 4 * f4) = wd[i]; *(LAS f32x4*)(bb + (1 * SC_TC + st) * 64 + 4 * f4) = kk; *(LAS f32x4*)(bb + (2 * SC_TC + st) * 64 + 4 * f4) = kk * aa[i]; \
                *(LAS f32x4*)(bb + (3 * SC_TC + st) * 64 + 4 * f4) = km; *(LAS f32x4*)(bb + (4 * SC_TC + st) * 64 + 4 * f4) = r4; } \
            if (tid2 < 128) { const int st = tid2 >> 2, g4_ = tid2 & 3; *(LAS f32x4*)(bb + 5 * SC_TC * 64 + st * 16 + 4 * g4_) = vld; } } while (0)
#define SC_BAR() asm volatile("s_waitcnt lgkmcnt(0)\n\ts_barrier" ::: "memory")
            SC_ISSUE(0); SC_COMMIT(0); SC_ISSUE(1); SC_COMMIT(1); SC_ISSUE(2);
            for (int c = 0; c < SEQ / SC_TC; ++c) { SC_BAR(); if (c + 2 < SEQ / SC_TC) SC_COMMIT(c + 2); if (c + 3 < SEQ / SC_TC) SC_ISSUE(c + 3); }
#undef SC_ISSUE
#undef SC_COMMIT
        } else {
            f32x2 sa = (f32x2){0.f, 0.f}, sb = (f32x2){0.f, 0.f}; float okeep = 0.f;
            for (int c = 0; c < SEQ / SC_TC; ++c) {
                asm volatile("s_waitcnt lgkmcnt(0)\n\ts_barrier" ::: "memory");
                const LAS float* bb = buf + (c % 3) * SC_BUF_FLOATS + 4 * kq; const LAS float* bv = buf + (c % 3) * SC_BUF_FLOATS + 5 * SC_TC * 64 + 4 * w + rl;
                float* op = OS + (m0 + (size_t)c * SC_TC + kq) * 1024 + col0 + 16 * q4 + 4 * w + rl;
                f32x4 W4[3], K4[3], B4[3], M4[3], R4[3]; float V1[3];
#define SC_FETCH(st) do { W4[(st) % 3] = *(const LAS f32x4*)(bb + (0 * SC_TC + (st)) * 64); K4[(st) % 3] = *(const LAS f32x4*)(bb + (1 * SC_TC + (st)) * 64); B4[(st) % 3] = *(const LAS f32x4*)(bb + (2 * SC_TC + (st)) * 64); \
                M4[(st) % 3] = *(const LAS f32x4*)(bb + (3 * SC_TC + (st)) * 64); R4[(st) % 3] = *(const LAS f32x4*)(bb + (4 * SC_TC + (st)) * 64); V1[(st) % 3] = bv[(st) * 16]; } while (0)
                SC_FETCH(0); SC_FETCH(1);
#pragma unroll
                for (int st = 0; st < SC_TC; ++st) {
                    if (st + 2 < SC_TC) SC_FETCH(st + 2);
                    const f32x4 w4 = W4[st % 3], kk4 = K4[st % 3], b4 = B4[st % 3], k4 = M4[st % 3], r4 = R4[st % 3]; const float vv = V1[st % 3];
                    const f32x2 wlo = (f32x2){w4.x, w4.y}, whi = (f32x2){w4.z, w4.w}, klo = (f32x2){kk4.x, kk4.y}, khi = (f32x2){kk4.z, kk4.w}, blo = (f32x2){b4.x, b4.y}, bhi = (f32x2){b4.z, b4.w},
                                mlo = (f32x2){k4.x, k4.y}, mhi = (f32x2){k4.z, k4.w}, rlo = (f32x2){r4.x, r4.y}, rhi = (f32x2){r4.z, r4.w};
                    const f32x2 dp = sa * klo + sb * khi; float d = dp.x + dp.y; d = row16_sum(d);
                    const f32x2 ta = sa * wlo + mlo * vv, tb = sb * whi + mhi * vv;
                    sa = ta - blo * d; sb = tb - bhi * d;
                    const f32x2 op2 = sa * rlo + sb * rhi; float o = op2.x + op2.y; o = row16_sum(o);
                    okeep = ((st & 15) == kq) ? o : okeep;
                    if ((st & 15) == 15) op[(size_t)(st & 16) * 1024] = okeep;
                }
#undef SC_FETCH
            }
        }
    }
    __syncthreads();
}

constexpr int AT_KSTR = 72;
constexpr int AT_TILE = 64 * AT_KSTR;
struct AttnState { f32x4 O[4][4]; float m[4], l[4]; };
constexpr float MFLOOR = -30000.0f;
__device__ __forceinline__ float hmax8(f32x4 a, f32x4 b) { return fmaxf(fmaxf(fmaxf(a.x, a.y), fmaxf(a.z, a.w)), fmaxf(fmaxf(b.x, b.y), fmaxf(b.z, b.w))); }
__device__ __forceinline__ float gmax4(float x) {
    auto r = __builtin_amdgcn_permlane16_swap(__float_as_uint(x), __float_as_uint(x), false, false); x = fmaxf(__uint_as_float(r[0]), __uint_as_float(r[1]));
    auto q = __builtin_amdgcn_permlane32_swap(__float_as_uint(x), __float_as_uint(x), false, false); return fmaxf(__uint_as_float(q[0]), __uint_as_float(q[1])); }
__device__ __forceinline__ float gsum4(float x) {
    auto r = __builtin_amdgcn_permlane16_swap(__float_as_uint(x), __float_as_uint(x), false, false); x = __uint_as_float(r[0]) + __uint_as_float(r[1]);
    auto q = __builtin_amdgcn_permlane32_swap(__float_as_uint(x), __float_as_uint(x), false, false); return __uint_as_float(q[0]) + __uint_as_float(q[1]); }
__device__ __forceinline__ unsigned gx16u(unsigned x, int g4) { auto r = __builtin_amdgcn_permlane16_swap(x, x, false, false); return (g4 & 1) ? r[0] : r[1]; }
__device__ __forceinline__ unsigned gx32u(unsigned x, int g4) { auto r = __builtin_amdgcn_permlane32_swap(x, x, false, false); return (g4 & 2) ? r[0] : r[1]; }
__device__ __forceinline__ float gx16(float x, int g4) { return __uint_as_float(gx16u(__float_as_uint(x), g4)); }
__device__ __forceinline__ float gx32(float x, int g4) { return __uint_as_float(gx32u(__float_as_uint(x), g4)); }
template <int MODE, bool EMASK>
__device__ __forceinline__ void attn_half(AttnState& st, const LAS bf16* Qw, const LAS bf16* Kt, const LAS bf16* Vt, int a, int keybase, int t, float bias,
                                          const float (&mfin)[4], const float (&linv)[4], f32x4 (&psum)[2], int lane) {
    __builtin_amdgcn_sched_barrier(0);
    asm volatile("" : "+v"(lane));
    const int kr = lane & 15, g4 = lane >> 4;
    bf16x8 kf[2][2];
#pragma unroll
    for (int ds = 0; ds < 2; ++ds)
#pragma unroll
        for (int x = 0; x < 2; ++x) kf[ds][x] = *(const LAS bf16x8*)(Kt + (32 * a + 16 * x + kr) * AT_KSTR + 32 * ds + 8 * g4);
    bool val[2][4];
    if (EMASK) {
#pragma unroll
        for (int x = 0; x < 2; ++x)
#pragma unroll
            for (int r = 0; r < 4; ++r) { const int key = keybase + 32 * a + 16 * x + 4 * g4 + r;
                if (MODE <= 1) val[x][r] = (16 * key + 31) <= t;
                else if (MODE == 2) val[x][r] = (key <= t);
                else val[x][r] = (key <= t) && (t - key < 512); }
    }
    bf16x8 pb[4];
#pragma unroll
    for (int hh = 0; hh < 4; ++hh) {
        f32x4 s0 = (f32x4){bias, bias, bias, bias}, s1 = s0;
#pragma unroll
        for (int ds = 0; ds < 2; ++ds) { const bf16x8 qv = *(const LAS bf16x8*)(Qw + 264 * kr + hh * 64 + 32 * ds + 8 * g4);
            s0 = __builtin_amdgcn_mfma_f32_16x16x32_bf16(kf[ds][0], qv, s0, 0, 0, 0); s1 = __builtin_amdgcn_mfma_f32_16x16x32_bf16(kf[ds][1], qv, s1, 0, 0, 0); }
        if (EMASK) {
#pragma unroll
            for (int r = 0; r < 4; ++r) { if (!val[0][r]) s0[r] = NEGBIG; if (!val[1][r]) s1[r] = NEGBIG; }
        }
        f32x4 p0, p1;
        if (MODE == 1) {
#pragma unroll
            for (int r = 0; r < 4; ++r) { p0[r] = __builtin_amdgcn_exp2f(s0[r] - mfin[hh]) * linv[hh]; p1[r] = __builtin_amdgcn_exp2f(s1[r] - mfin[hh]) * linv[hh]; }
            psum[0] += p0; psum[1] += p1;
        } else {
            const float mloc = gmax4(hmax8(s0, s1)); const float mold = st.m[hh]; const float mnew = fmaxf(mold, mloc);
#pragma unroll
            for (int r = 0; r < 4; ++r) { p0[r] = __builtin_amdgcn_exp2f(s0[r] - mnew); p1[r] = __builtin_amdgcn_exp2f(s1[r] - mnew); }
            if (__ballot(mnew > mold) != 0ull) {
                const float alpha = __builtin_amdgcn_exp2f(mold - mnew); st.l[hh] *= alpha;
                if (MODE != 0) {
#pragma unroll
                    for (int dt = 0; dt < 4; ++dt) st.O[hh][dt] = st.O[hh][dt] * alpha;
                }
            }
            st.l[hh] += ((p0.x + p0.y) + (p0.z + p0.w)) + ((p1.x + p1.y) + (p1.z + p1.w));
            st.m[hh] = mnew;
        }
        if (MODE != 0) {
            v4u w; w.x = pk2(p0.x, p0.y); w.y = pk2(p0.z, p0.w); w.z = pk2(p1.x, p1.y); w.w = pk2(p1.z, p1.w);
            pb[hh] = __builtin_bit_cast(bf16x8, w);
        }
        __builtin_amdgcn_sched_barrier(0);
    }
    if (MODE != 0) {
#pragma unroll
        for (int dt = 0; dt < 4; ++dt) {
            const v2u lo = *(const LAS v2u*)(Vt + (16 * dt + kr) * AT_KSTR + 32 * a + 4 * g4);
            const v2u hi = *(const LAS v2u*)(Vt + (16 * dt + kr) * AT_KSTR + 32 * a + 16 + 4 * g4);
            const v4u vv = (v4u){lo.x, lo.y, hi.x, hi.y}; const bf16x8 vf = __builtin_bit_cast(bf16x8, vv);
#pragma unroll
            for (int hh = 0; hh < 4; ++hh) st.O[hh][dt] = __builtin_amdgcn_mfma_f32_16x16x32_bf16(vf, pb[hh], st.O[hh][dt], 0, 0, 0);
        }
    }
    __builtin_amdgcn_sched_barrier(0);
}
__device__ __forceinline__ void attn_reset(AttnState& st) {
#pragma unroll
    for (int hh = 0; hh < 4; ++hh) { st.m[hh] = MFLOOR; st.l[hh] = 0.f;
#pragma unroll
        for (int dt = 0; dt < 4; ++dt) st.O[hh][dt] = (f32x4){0.f, 0.f, 0.f, 0.f}; }
}
template <int STAGE>
__device__ __forceinline__ void attn_store(AttnState& st, float* ACC, bf16* MIX, const float* GATE, int mrow0, int g) {
    const int lane = fresh_lane_id(), g4 = lane >> 4; const size_t m = (size_t)(mrow0 + (lane & 15));
    float* ap = ACC + m * 1024 + g * 256 + 4 * g4; bf16* mp = MIX + m * DM + 1024 + g * 256 + 4 * g4; const float* gp = GATE + m * 48 + g * 12;
#pragma unroll
    for (int hh = 0; hh < 4; ++hh) {
        float sc = gp[hh * 3 + STAGE];
        if (STAGE != 0) { const float lt = gsum4(st.l[hh]); sc = lt > 0.f ? sc / lt : 0.f; }
#pragma unroll
        for (int dt = 0; dt < 4; ++dt) { f32x4 v = st.O[hh][dt] * sc;
            if (STAGE != 0) v = v + *(const f32x4*)(ap + hh * 64 + 16 * dt);
            if (STAGE != 2) *(f32x4*)(ap + hh * 64 + 16 * dt) = v;
            else { v2u w; w.x = pk2(v.x, v.y); w.y = pk2(v.z, v.w); *(v2u*)(mp + hh * 64 + 16 * dt) = w; } }
        __builtin_amdgcn_sched_barrier(0);
    }
}
__device__ __forceinline__ void phase_nsa(Frame& F) {
    const bf16* QN = (const bf16*)(F.ws + WS_QN); const bf16* KS = (const bf16*)(F.ws + WS_KS); const bf16* KW = (const bf16*)(F.ws + WS_KW);
    const bf16* VST = (const bf16*)(F.ws + WS_VST); const bf16* VWT = (const bf16*)(F.ws + WS_VWT); const bf16* KC = (const bf16*)(F.ws + WS_KC); const bf16* VCT = (const bf16*)(F.ws + WS_VCT);
    float* ACC = (float*)(F.ws + WS_OCMP); bf16* MIX = (bf16*)(F.ws + WS_MIX); const float* GATE = (const float*)(F.ws + WS_GATE);
    LAS bf16* Kt = (LAS bf16*)F.lds; LAS bf16* Vt = Kt + 2 * AT_TILE;
    const int w = F.wave;
    for (int item = F.vcu; item < 256; item += F.G) {
        const int tidv = w * 64 + fresh_lane_id();
        const int lane = tidv & 63, qc = lane & 15, g4 = lane >> 4;
        const int srow = tidv >> 3, spiece = tidv & 7;
        const unsigned koff = (unsigned)(srow * 64 + spiece * 8), voff = (unsigned)(srow * 2048 + spiece * 8), loff = (unsigned)(srow * AT_KSTR + spiece * 8);
        const int bg = item >> 4, qb = 15 - (item & 15), b = bg >> 2, g = bg & 3;
        const bf16* ksb = KS + (size_t)bg * 2048 * 64; const bf16* kwb = KW + (size_t)bg * 2048 * 64; const bf16* vsb = VST + (size_t)bg * 64 * 2048; const bf16* vwb = VWT + (size_t)bg * 64 * 2048;
        const int q0 = qb * 128, t0 = q0 + 16 * w, t = t0 + qc; const size_t m = (size_t)b * 2048 + t;
        const LAS bf16* Qw = Kt + 4 * AT_TILE + w * (16 * 264);
#pragma unroll
        for (int hh = 0; hh < 4; ++hh)
#pragma unroll
            for (int ds = 0; ds < 2; ++ds) *(LAS bf16x8*)((LAS bf16*)Qw + 264 * qc + hh * 64 + 32 * ds + 8 * g4) = *(const bf16x8*)(QN + m * 1024 + (g * 4 + hh) * 64 + 32 * ds + 8 * g4);
        AttnState st; unsigned selmask = 0u;
        float mfin[4] = {0.f, 0.f, 0.f, 0.f}, linv[4] = {0.f, 0.f, 0.f, 0.f}; f32x4 psd[2];
        __syncthreads();
#pragma unroll
        for (int jj = 0; jj < 2; ++jj) {
            *(LAS v4u*)(Kt + jj * AT_TILE + loff) = *(const v4u*)(KC + (size_t)bg * 128 * 64 + 64 * 64 * jj + koff);
            *(LAS v4u*)(Vt + jj * AT_TILE + loff) = *(const v4u*)(VCT + (size_t)bg * 64 * 128 + 64 * jj + (unsigned)(srow * 128 + spiece * 8));
        }
        __syncthreads();
        attn_reset(st);
#pragma unroll
        for (int jj = 0; jj < 2; ++jj)
#pragma unroll
            for (int a = 0; a < 2; ++a) attn_half<0, true>(st, Qw, Kt + jj * AT_TILE, Vt + jj * AT_TILE, a, 64 * jj, t, 0.f, mfin, linv, psd, lane);
#pragma unroll
        for (int hh = 0; hh < 4; ++hh) { const float lt = gsum4(st.l[hh]); mfin[hh] = st.m[hh]; linv[hh] = lt > 0.f ? 1.0f / lt : 0.f; }
        attn_reset(st);
        float imp[8]; float aprev = 0.f; const int cur = t >> 6;
#pragma unroll
        for (int jj = 0; jj < 2; ++jj)
#pragma unroll
            for (int a = 0; a < 2; ++a) { f32x4 pp[2]; pp[0] = (f32x4){0.f, 0.f, 0.f, 0.f}; pp[1] = pp[0];
                attn_half<1, true>(st, Qw, Kt + jj * AT_TILE, Vt + jj * AT_TILE, a, 64 * jj, t, 0.f, mfin, linv, pp, lane);
#pragma unroll
                for (int x = 0; x < 2; ++x) { const int kt = 4 * jj + 2 * a + x; const float x3 = pp[x].w; const float n16 = gx16(x3, g4); const float up = (g4 & 1) ? n16 : gx32(n16, g4);     const float prev3 = (g4 != 0) ? up : aprev; aprev = up;
                    const float v = pp[x].x + pp[x].y + pp[x].z + 0.5f * pp[x].w + 0.5f * prev3;
                    const int blk = 4 * kt + g4; const bool forced = (blk == 0) || (blk == cur) || (blk == cur - 1); const bool causal = blk <= cur;
                    imp[kt] = forced ? 1e4f : (causal ? v : -1.0f); } }
        attn_store<0>(st, ACC, MIX, GATE, b * 2048 + t0, g);
        {
          unsigned taken = 0u;
#pragma unroll 1
          for (int round = 0; round < 8; ++round) {
              float bv = -3.0e38f; int bi = 1024;
#pragma unroll
              for (int kt = 0; kt < 8; ++kt) { const bool free_ = !((taken >> kt) & 1u); if (free_ && imp[kt] > bv) { bv = imp[kt]; bi = 4 * kt + g4; } }
#pragma unroll
              for (int off = 16; off <= 32; off <<= 1) { const float ov = (off == 16) ? gx16(bv, g4) : gx32(bv, g4); const int oi = (int)((off == 16) ? gx16u((unsigned)bi, g4) : gx32u((unsigned)bi, g4)); if (ov > bv || (ov == bv && oi < bi)) { bv = ov; bi = oi; } }
              selmask |= 1u << (bi & 31);
              if ((bi & 3) == g4) taken |= 1u << (bi >> 2);
          } }
        attn_reset(st);
        { const int jhi = (q0 >> 6) + 1;
          v4u kreg = *(const v4u*)(ksb + koff), vreg = *(const v4u*)(vsb + voff);
          __syncthreads();
          *(LAS v4u*)(Kt + loff) = kreg; *(LAS v4u*)(Vt + loff) = vreg;
          __syncthreads();
          for (int j = 0; j <= jhi; ++j) {
              const int cb = (j & 1) * AT_TILE, nb = AT_TILE - cb;
              if (j < jhi) { kreg = *(const v4u*)(ksb + 4096 * (j + 1) + koff); vreg = *(const v4u*)(vsb + 64 * (j + 1) + voff); }
              const bool mine = (selmask >> j) & 1u;
              const bool need = (64 * j <= t0 + 15) && (__ballot(mine) != 0ull);
              if (need) {
                  const float bias = mine ? 0.f : NEGBIG;
                  if (64 * j + 63 > t0) {
#pragma unroll
                      for (int a = 0; a < 2; ++a) attn_half<2, true>(st, Qw, Kt + cb, Vt + cb, a, 64 * j, t, bias, mfin, linv, psd, lane);
                  } else {
#pragma unroll
                      for (int a = 0; a < 2; ++a) attn_half<2, false>(st, Qw, Kt + cb, Vt + cb, a, 64 * j, t, bias, mfin, linv, psd, lane);
                  }
              }
              if (j < jhi) { *(LAS v4u*)(Kt + nb + loff) = kreg; *(LAS v4u*)(Vt + nb + loff) = vreg; }
              __syncthreads();
          } }
        attn_store<1>(st, ACC, MIX, GATE, b * 2048 + t0, g);
        attn_reset(st);
        { const int jlo = q0 >= 512 ? ((q0 - 512) >> 6) : 0, jhi = (q0 >> 6) + 1;
          v4u kreg = *(const v4u*)(kwb + 4096 * jlo + koff), vreg = *(const v4u*)(vwb + 64 * jlo + voff);
          *(LAS v4u*)(Kt + loff) = kreg; *(LAS v4u*)(Vt + loff) = vreg;
          __syncthreads();
          for (int j = jlo; j <= jhi; ++j) {
              const int cb = ((j - jlo) & 1) * AT_TILE, nb = AT_TILE - cb;
              if (j < jhi) { kreg = *(const v4u*)(kwb + 4096 * (j + 1) + koff); vreg = *(const v4u*)(vwb + 64 * (j + 1) + voff); }
              const bool need = (64 * j <= t0 + 15) && (64 * j + 63 >= t0 - 511);
              if (need) {
                  if ((64 * j + 63 > t0) || (64 * j <= t0 - 497)) {
#pragma unroll
                      for (int a = 0; a < 2; ++a) attn_half<3, true>(st, Qw, Kt + cb, Vt + cb, a, 64 * j, t, 0.f, mfin, linv, psd, lane);
                  } else {
#pragma unroll
                      for (int a = 0; a < 2; ++a) attn_half<3, false>(st, Qw, Kt + cb, Vt + cb, a, 64 * j, t, 0.f, mfin, linv, psd, lane);
                  }
              }
              if (j < jhi) { *(LAS v4u*)(Kt + nb + loff) = kreg; *(LAS v4u*)(Vt + nb + loff) = vreg; }
              __syncthreads();
          } }
        attn_store<2>(st, ACC, MIX, GATE, b * 2048 + t0, g);
    }
    __syncthreads();
}
__device__ __forceinline__ void phase_mixprep(Frame& F, ArgP a, int l) {
    const int gw = F.vcu * NWAVES + F.wave, NGW = F.G * NWAVES, lane = F.lane;
    const float* OS = (const float*)(F.ws + WS_OS); const float* GG = (const float*)(F.ws + WS_GG); const float* VV = (const float*)(F.ws + (l == 0 ? WS_VF : WS_V));
    const float* BON = (const float*)(F.ws + WS_BONUS); const float* lg = INP(a, 14) + l * 1024; const float* lb = INP(a, 15) + l * 1024;
    bf16* MIX = (bf16*)(F.ws + WS_MIX);
    for (int m = gw; m < MTOK; m += NGW) {
        const int h = lane >> 2; f32x4 o4[4]; float s = 0.f;
#pragma unroll
        for (int q = 0; q < 4; ++q) { o4[q] = *(const f32x4*)(OS + (size_t)m * 1024 + 16 * lane + 4 * q); s += (o4[q].x + o4[q].y) + (o4[q].z + o4[q].w); }
        const float mean = quad_sum(s) * (1.0f / 64.0f); float s2 = 0.f;
#pragma unroll
        for (int q = 0; q < 4; ++q) { o4[q] = o4[q] - mean; s2 += (o4[q].x * o4[q].x + o4[q].y * o4[q].y) + (o4[q].z * o4[q].z + o4[q].w * o4[q].w); }
        const float rstd = 1.0f / sqrtf(quad_sum(s2) * (1.0f / 64.0f) + GN_EPS); const float bon = BON[(size_t)m * 16 + h];
#pragma unroll
        for (int q = 0; q < 4; ++q) { const int col = 16 * lane + 4 * q; const size_t o = (size_t)m * 1024 + col;
            const f32x4 r = (o4[q] * rstd * *(const f32x4*)(lg + col) + *(const f32x4*)(lb + col) + *(const f32x4*)(VV + o) * bon) * *(const f32x4*)(GG + o);
            v2u w; w.x = pk2(r.x, r.y); w.y = pk2(r.z, r.w); *(v2u*)(MIX + (size_t)m * DM + col) = w;
}
    }
}
__device__ __forceinline__ void phase_ln(Frame& F, const float* Z, const float* g, const float* bta, float* X, const float* sc0, const float* sh0, bf16* H) {
    const int gw = F.vcu * NWAVES + F.wave, NGW = F.G * NWAVES, lane = F.lane;
    for (int m = gw; m < MTOK; m += NGW) {
        const int b = m >> 11; const float* zr = Z + (size_t)m * DM; f32x4 v[8]; float s = 0.f;
#pragma unroll
        for (int j = 0; j < 8; ++j) { v[j] = *(const f32x4*)(zr + 4 * (lane + 64 * j)); s += (v[j].x + v[j].y) + (v[j].z + v[j].w); }
        const float mean = wave_sum(s) * (1.0f / DM); float s2 = 0.f;
#pragma unroll
        for (int j = 0; j < 8; ++j) { v[j] = v[j] - mean; s2 += (v[j].x * v[j].x + v[j].y * v[j].y) + (v[j].z * v[j].z + v[j].w * v[j].w); }
        const float rstd = 1.0f / sqrtf(wave_sum(s2) * (1.0f / DM) + LN_EPS);
#pragma unroll
        for (int j = 0; j < 8; ++j) { const int col = 4 * (lane + 64 * j);
            const f32x4 x = v[j] * rstd * *(const f32x4*)(g + col) + *(const f32x4*)(bta + col);
            *(f32x4*)(X + (size_t)m * DM + col) = x;
            if (sc0) { const f32x4 h = x * (*(const f32x4*)(sc0 + (size_t)b * 12288 + col) + 1.0f) + *(const f32x4*)(sh0 + (size_t)b * 12288 + col);
                v2u w; w.x = pk2(h.x, h.y); w.y = pk2(h.z, h.w); *(v2u*)(H + (size_t)m * DM + col) = w; } }
    }
}
#ifdef MK_CHECK
constexpr int CW_CHK = 2048;
__device__ __forceinline__ float wave_max(float v) {
#pragma unroll
    for (int o = 1; o < 64; o <<= 1) v = fmaxf(v, __shfl_xor(v, o));
    return v;
}
__device__ __forceinline__ void nsa_check(Frame& F) {
    if (F.wave != 0) return;
    const bf16* QN = (const bf16*)(F.ws + WS_QN); const bf16* KS = (const bf16*)(F.ws + WS_KS); const bf16* KW = (const bf16*)(F.ws + WS_KW);
    const bf16* VST = (const bf16*)(F.ws + WS_VST); const bf16* VWT = (const bf16*)(F.ws + WS_VWT); const bf16* KC = (const bf16*)(F.ws + WS_KC); const bf16* VCT = (const bf16*)(F.ws + WS_VCT);
    const bf16* MIX = (const bf16*)(F.ws + WS_MIX); const float* GATE = (const float*)(F.ws + WS_GATE);
    LAS float* sc = (LAS float*)F.lds;
    LAS float* qs = sc + 2048;
    LAS float* ps = qs + 64;
    const int lane = F.lane;
    const int tlist[16] = {0, 7, 30, 31, 47, 63, 64, 129, 511, 512, 575, 1000, 1023, 1407, 1999, 2047};
    int tsel = 0;
#pragma unroll
    for (int i = 0; i < 16; ++i) if (((int)blockIdx.x & 15) == i) tsel = tlist[i];
    const int t = tsel, b = ((int)blockIdx.x >> 4) & 3, g = ((int)blockIdx.x >> 6) & 3, bg = b * 4 + g; const size_t m = (size_t)b * 2048 + t;
    for (int i = lane; i < 128; i += 64) ps[i] = 0.f;
    float oc[4], osl[4], ow[4];
    for (int hh = 0; hh < 4; ++hh) {
        qs[lane] = bf2f(QN[m * 1024 + (g * 4 + hh) * 64 + lane]);
        float mx = -3e38f;
        for (int c = lane; c < 127; c += 64) { float s = -3e38f; if (16 * c + 31 <= t) { s = 0.f; for (int d = 0; d < 64; ++d) s += qs[d] * bf2f(KC[(size_t)(bg * 128 + c) * 64 + d]); } sc[c] = s; mx = fmaxf(mx, s); }
        mx = wave_max(mx); float l = 0.f;
        for (int c = lane; c < 127; c += 64) { const float p = (16 * c + 31 <= t) ? exp2f(sc[c] - mx) : 0.f; sc[c] = p; l += p; }
        l = wave_sum(l); const float il = l > 0.f ? 1.f / l : 0.f; float o = 0.f;
        for (int c = lane; c < 127; c += 64) { sc[c] *= il; ps[c] += sc[c]; }
        for (int c = 0; c < 127; ++c) o += sc[c] * bf2f(VCT[(size_t)(bg * 64 + lane) * 128 + c]);
        oc[hh] = o;
    }
    unsigned selmask = 0u;
    { const int cur = t >> 6; float imp = 0.f;
      if (lane < 32) { const int j = lane; float v = 0.f;
          for (int i = 4 * j - 1; i <= 4 * j + 3; ++i) if (i >= 0 && i < 127) v += ps[i] * ((i == 4 * j - 1 || i == 4 * j + 3) ? 0.5f : 1.0f);
          const bool forced = (j == 0) || (j == cur) || (j == cur - 1); imp = forced ? 1e4f : ((j <= cur) ? v : -1.0f); }
      bool taken = false;
      for (int r = 0; r < 8; ++r) { float bv = (lane < 32 && !taken) ? imp : -3e38f; int bi = lane;
          for (int o = 1; o < 64; o <<= 1) { const float ov = __shfl_xor(bv, o); const int oi = __shfl_xor(bi, o); if (ov > bv || (ov == bv && oi < bi)) { bv = ov; bi = oi; } }
          selmask |= 1u << (bi & 31); if (lane == bi) taken = true; } }
    for (int br = 0; br < 2; ++br) {
        const bf16* Kb = (br == 0 ? KS : KW) + (size_t)bg * 2048 * 64; const bf16* Vb = (br == 0 ? VST : VWT) + (size_t)bg * 64 * 2048;
        for (int hh = 0; hh < 4; ++hh) {
            qs[lane] = bf2f(QN[m * 1024 + (g * 4 + hh) * 64 + lane]);
            float mx = -3e38f;
            for (int s0 = lane; s0 < 2048; s0 += 64) { const bool ok = (s0 <= t) && (br == 0 ? ((selmask >> (s0 >> 6)) & 1u) != 0u : (t - s0 < 512));
                float s = -3e38f; if (ok) { s = 0.f; for (int d = 0; d < 64; ++d) s += qs[d] * bf2f(Kb[(size_t)s0 * 64 + d]); } sc[s0] = s; mx = fmaxf(mx, s); }
            mx = wave_max(mx); float l = 0.f;
            for (int s0 = lane; s0 < 2048; s0 += 64) { const float p = (sc[s0] > -1e38f) ? exp2f(sc[s0] - mx) : 0.f; sc[s0] = p; l += p; }
            l = wave_sum(l); const float il = l > 0.f ? 1.f / l : 0.f; float o = 0.f;
            for (int s0 = 0; s0 <= t; ++s0) o += sc[s0] * bf2f(Vb[(size_t)lane * 2048 + s0]);
            if (br == 0) osl[hh] = o * il; else ow[hh] = o * il;
        }
    }
    bool bad = false;
    for (int hh = 0; hh < 4; ++hh) { const float* gp = GATE + m * 48 + (g * 4 + hh) * 3;
        const float ref = gp[0] * oc[hh] + gp[1] * osl[hh] + gp[2] * ow[hh]; const float got = bf2f(MIX[m * DM + 1024 + (g * 4 + hh) * 64 + lane]);
        const float err = fabsf(got - ref); const float rms = sqrtf(wave_sum(ref * ref) * (1.f / 64.f));
        if (!(err <= 0.03f * fabsf(ref) + 0.02f * rms + 1e-6f)) bad = true; }
    if (__ballot(bad) != 0ull && lane == 0) atomicOr((unsigned*)(F.ctl + CW_CHK), 1u);
}
#endif

#define GEMM_CALL(EPI, SCHED, g, S, E) pg8::gemm_phase<EPI, SCHED, true, true>(F.lds, F.wave, g, S, E)
__global__ void __launch_bounds__(NWAVES * 64, 2) mk_fwd(Args args_byval) {
    ArgP args = (ArgP)__builtin_amdgcn_kernarg_segment_ptr();
    extern __shared__ __attribute__((aligned(16))) unsigned char lds[];
    Frame F;
    F.lds = (LAS unsigned char*)lds;
    F.MISC = (volatile LAS unsigned*)(F.lds + MISC_OFF);
    F.tid = threadIdx.x; F.lane = F.tid & 63; F.wave = __builtin_amdgcn_readfirstlane(F.tid >> 6);
    F.G = gridDim.x; { const int bx = blockIdx.x; F.vcu = (F.G % 8 == 0) ? (bx % 8) * (F.G / 8) + bx / 8 : bx; }
    F.ws = (GAS unsigned char*)args->ws; F.ctl = (gu32*)(F.ws + WS_CTL);
    for (int u = F.tid; u < (LDS_BYTES - LDSCTL_OFF) / 4; u += NWAVES * 64) ((LAS unsigned*)(F.lds + LDSCTL_OFF))[u] = 0u;
    __syncthreads();
    XcdBarrier bar; bar.bar = (unsigned*)(F.ctl + CW_BAR); bar.x = 0; bar.st = nullptr;
    if (!MK_PER_PHASE) bar = xcd_barrier_post((unsigned*)(F.ctl + CW_BAR), F.MISC + 8, F.wave);
    const int lo = args->ph_lo, hi = args->ph_hi;
#ifndef MK_SUB
#define MK_SUB 31
#endif
#ifndef MK_PHASE_MASK
#define MK_PHASE_MASK 0x7fff
#endif
#define PH_ON(j) (((MK_PHASE_MASK) >> (j)) & 1)
#ifndef MK_REPEAT
#define MK_REPEAT 0
#endif
#define REP(j) _Pragma("nounroll") for (int rep_ = 0; rep_ < 1 + (((MK_REPEAT) >> (j)) & 1); ++rep_)
#define IN(k) (lo <= (k) && (k) < hi)
#define SEAM(k) do { if (IN((k) + 1)) { xcd_barrier(bar, F.wave); if ((MK_REPEAT >> 17) & 1) xcd_barrier(bar, F.wave); } } while (0)
#define REFRESH() do { asm volatile("" : "+s"(F.wave)); F.lane = fresh_lane_id(); F.tid = F.wave * 64 + F.lane; asm volatile("" : "+s"(F.vcu)); asm volatile("" : "+s"(F.ws)); asm volatile("" : "+s"(args)); } while (0)
    const int bx = (int)blockIdx.x, G = F.G;

    if (PH_ON(0) && IN(0)) { REFRESH(); REP(0) phase_pre0(F, args); SEAM(0); }
    if (PH_ON(1) && IN(1)) { REFRESH(); phase_pre1(F, args); SEAM(1); }

    for (int l = 0; l < DEPTH; ++l) {
        const int pb = 2 + 13 * l;
        GAS unsigned char* wl = wlayer(F, l);
        const float* Xin = (l == 0) ? INP(args, 0) : (const float*)(F.ws + WS_XA);
        if (PH_ON(2) && IN(pb + 0)) { REFRESH();
            pg8::Gemm g{(const bf16*)(F.ws + WS_H), (const bf16*)(wl + WL_IN), DM, DM, DM}; pg8::StaticOrder S; S.init(MTOK, NINP, G, bx);
            pg8::EpiF4<FStoreF32> E{{(float*)(F.ws + WS_U), NINP}};
            REP(2) GEMM_CALL(pg8::EpiF4<FStoreF32>, pg8::StaticOrder, g, S, E);
            SEAM(pb + 0);
        }
        if (PH_ON(3) && IN(pb + 1)) { REFRESH(); REP(3) phase_prep(F, args, l); SEAM(pb + 1); }
        if (PH_ON(4) && IN(pb + 2)) { REFRESH(); REP(4) {
            if (MK_SUB & 1) { pg8::Gemm g{(const bf16*)(F.ws + WS_KCH), (const bf16*)(wl + WL_C1), 2048, 1024, 2048}; pg8::ListOrder S{16, G, bx, 2};
              pg8::EpiF8<FCmp1> E{{(bf16*)(F.ws + WS_CH), (const float*)(F.ws + WS_B1) + l * 512}};
              GEMM_CALL(pg8::EpiF8<FCmp1>, pg8::ListOrder, g, S, E); }
            if ((MK_SUB & 2) && l > 0) { pg8::Gemm g{(const bf16*)(F.ws + WS_VB), (const bf16*)(wl + WL_V1), 1024, 1024, 1024}; pg8::ListOrder S{32, G, (bx + G - 16) % G, 1};
              pg8::EpiF8<FStoreBf8> E{{(bf16*)(F.ws + WS_V1O), 256}};
              GEMM_CALL(pg8::EpiF8<FStoreBf8>, pg8::ListOrder, g, S, E); }
            if (MK_SUB & 4) { pg8::Gemm g{(const bf16*)(F.ws + WS_LA), (const bf16*)(wl + WL_LORA), 256, 256, 256}; pg8::ListOrder S{384, G, (bx + G - 48) % G, 0};
              pg8::EpiF4<FLora> E{{(float*)(F.ws + WS_WD), (float*)(F.ws + WS_AA), (float*)(F.ws + WS_GG), INP(args, 6) + l * 1024, INP(args, 8) + l * 1024}};
              GEMM_CALL(pg8::EpiF4<FLora>, pg8::ListOrder, g, S, E); }
            }
            SEAM(pb + 2);
        }
        if (PH_ON(5) && IN(pb + 3)) { REFRESH();
            if ((MK_SUB & 8) && l > 0) { pg8::Gemm g{(const bf16*)(F.ws + WS_V1O), (const bf16*)(wl + WL_V2), 256, 256, 256}; pg8::ListOrder S{128, G, bx, 3};
              pg8::EpiF4<FV2> E{{(float*)(F.ws + WS_V), (const float*)(F.ws + WS_VF), INP(args, 16) + (l - 1) * 1024}};
              GEMM_CALL(pg8::EpiF4<FV2>, pg8::ListOrder, g, S, E); }
            if (MK_SUB & 16) { pg8::Gemm g{(const bf16*)(F.ws + WS_CH), (const bf16*)(wl + WL_C2), 256, 256, 256}; pg8::ListOrder S{16, G, (bx + G - 128) % G, 2};
              pg8::EpiF4<FCmp2> E{{(bf16*)(F.ws + WS_KC), (bf16*)(F.ws + WS_VCT)}};
              GEMM_CALL(pg8::EpiF4<FCmp2>, pg8::ListOrder, g, S, E); }
            SEAM(pb + 3);
        }
        if (PH_ON(7) && IN(pb + 5)) { REFRESH(); REP(7) phase_scan(F, args, l); }
        if (PH_ON(8) && IN(pb + 6)) { REFRESH(); REP(8) phase_nsa(F); SEAM(pb + 6); }
#ifdef MK_CHECK
        if (l == MK_CHECK - 1) { REFRESH(); nsa_check(F); xcd_barrier(bar, F.wave); }
#endif
        if (PH_ON(9) && IN(pb + 7)) { REFRESH(); REP(9) phase_mixprep(F, args, l); SEAM(pb + 7); }
        if (PH_ON(10) && IN(pb + 8)) { REFRESH();
            pg8::Gemm g{(const bf16*)(F.ws + WS_MIX), (const bf16*)(wl + WL_OUT), DM, DM, DM}; pg8::StaticOrder S; S.init(MTOK, DM, G, bx);
            pg8::EpiF4<FResid> E{{(float*)(F.ws + WS_Z), Xin, modp(F, l, 0, 2)}};
            REP(10) GEMM_CALL(pg8::EpiF4<FResid>, pg8::StaticOrder, g, S, E);
            SEAM(pb + 8);
        }
        if (PH_ON(11) && IN(pb + 9)) { REFRESH(); REP(11) phase_ln(F, (const float*)(F.ws + WS_Z), INP(args, 23) + l * DM, INP(args, 24) + l * DM, (float*)(F.ws + WS_XB), modp(F, l, 0, 4), modp(F, l, 0, 3), (bf16*)(F.ws + WS_H)); SEAM(pb + 9); }
        if (PH_ON(12) && IN(pb + 10)) { REFRESH();
            pg8::Gemm g{(const bf16*)(F.ws + WS_H), (const bf16*)(wl + WL_W1), DM, DM, DM}; pg8::StaticOrder S; S.init(MTOK, DFF, G, bx);
            pg8::EpiF8<FRelu2> E{{(bf16*)(F.ws + WS_U)}};
            REP(12) GEMM_CALL(pg8::EpiF8<FRelu2>, pg8::StaticOrder, g, S, E);
            SEAM(pb + 10);
        }
        if (PH_ON(13) && IN(pb + 11)) { REFRESH();
            pg8::Gemm g{(const bf16*)(F.ws + WS_U), (const bf16*)(wl + WL_W2), DFF, DFF, DFF}; pg8::StaticOrder S; S.init(MTOK, DM, G, bx);
            pg8::EpiF4<FResid> E{{(float*)(F.ws + WS_Z), (const float*)(F.ws + WS_XB), modp(F, l, 0, 5)}};
            REP(13) GEMM_CALL(pg8::EpiF4<FResid>, pg8::StaticOrder, g, S, E);
            SEAM(pb + 11);
        }
        if (PH_ON(14) && IN(pb + 12)) { REFRESH();
            const bool lastl = (l == DEPTH - 1);
            REP(14) phase_ln(F, (const float*)(F.ws + WS_Z), INP(args, 27) + l * DM, INP(args, 28) + l * DM, lastl ? (float*)(GAS float*)args->out : (float*)(F.ws + WS_XA),
                     lastl ? nullptr : modp(F, l + 1, 0, 1), lastl ? nullptr : modp(F, l + 1, 0, 0), (bf16*)(F.ws + WS_H));
            if (!lastl) SEAM(pb + 12);
        }
    }
#ifdef MK_CHECK
    xcd_barrier(bar, F.wave);
    if (blockIdx.x == 0 && F.tid == 0 && __hip_atomic_load((unsigned*)(F.ctl + CW_CHK), RLX_AGENT) != 0u) args->out[0] = __builtin_nanf("");
#endif
#undef IN
#undef SEAM
}

extern "C" void kernel_launch(void* const* d_in, const int* in_sizes, int n_in, void* d_out, int out_size, void* d_ws, size_t ws_size, hipStream_t stream) {
    static int grid = 0;
    if (grid == 0) {
        if (n_in != 29 || in_sizes[0] != MTOK * DM || out_size != MTOK * DM || ws_size < WS_END) {
            fprintf(stderr, "kernel_launch: unexpected problem: n_in %d in0 %d out %d ws %zu (need %zu); nothing launched\n", n_in, n_in > 0 ? in_sizes[0] : -1, out_size, ws_size, (size_t)WS_END); grid = -1; return; }
        int dev = 0, cus = 0, per_cu = 0;
        if (hipGetDevice(&dev) != hipSuccess || hipDeviceGetAttribute(&cus, hipDeviceAttributeMultiprocessorCount, dev) != hipSuccess) { fprintf(stderr, "kernel_launch: device query failed\n"); grid = -1; return; }
        if (hipFuncSetAttribute((const void*)mk_fwd, hipFuncAttributeMaxDynamicSharedMemorySize, LDS_BYTES) != hipSuccess) { fprintf(stderr, "kernel_launch: hipFuncSetAttribute failed\n"); grid = -1; return; }
        if (hipOccupancyMaxActiveBlocksPerMultiprocessor(&per_cu, (const void*)mk_fwd, NWAVES * 64, LDS_BYTES) != hipSuccess || per_cu < 1)
            fprintf(stderr, "kernel_launch: note: occupancy query reports %d workgroups per CU\n", per_cu);
        (void)hipGetLastError();
        grid = cus;
    }
    if (grid < 0) return;
    if (hipMemsetAsync((char*)d_ws + WS_CTL, 0, CTL_ZERO_BYTES, stream) != hipSuccess) { fprintf(stderr, "kernel_launch: memset failed\n"); return; }
    Args a{};
    for (int i = 0; i < 29; ++i) a.in[i] = (const float*)d_in[i];
    a.out = (float*)d_out; a.ws = (unsigned char*)d_ws;
#if MK_PER_PHASE
    for (int p = 0; p < N_PHASES; ++p) { a.ph_lo = p; a.ph_hi = p + 1; hipLaunchKernelGGL(mk_fwd, dim3(grid), dim3(NWAVES * 64), LDS_BYTES, stream, a); }
#else
    a.ph_lo = 0; a.ph_hi = N_PHASES;
    hipLaunchKernelGGL(mk_fwd, dim3(grid), dim3(NWAVES * 64), LDS_BYTES, stream, a);
#endif
    const hipError_t le = hipPeekAtLastError();
    if (le != hipSuccess) fprintf(stderr, "kernel_launch: launch failed: %s\n", hipGetErrorName(le));
}
```
